# Optimizing an MI355X kernel written in HIP

```python
import jax, jax.numpy as jnp
from jax import lax
import numpy as np

D_MODEL = 1024
BATCH = 2
SEQ = 8192
DEPTH = 1

GRID_W = 64
CTX_LEN = 256
N_HEADS = 8
N_KV_HEADS = 2
HEAD_DIM = 64
GQA_GROUP = N_HEADS // N_KV_HEADS
ATT_WIDTH = N_HEADS * HEAD_DIM
KV_WIDTH = N_KV_HEADS * HEAD_DIM
CONV_WIDTH = D_MODEL - ATT_WIDTH
CONV_GROUPS = 8
CONV_K = 3
WINDOW = 128
BLOCK = 128
ROPE_THETA = 10000.0
N_EXPERTS = 16
EC_CAPACITY_FACTOR = 2
D_EXPERT = 1024
EPS = 1e-6
IN_WIDTH = ATT_WIDTH + 2 * KV_WIDTH + 3 * CONV_WIDTH
SPLIT_POINTS = [ATT_WIDTH, ATT_WIDTH + KV_WIDTH, ATT_WIDTH + 2 * KV_WIDTH,
                ATT_WIDTH + 2 * KV_WIDTH + CONV_WIDTH, ATT_WIDTH + 2 * KV_WIDTH + 2 * CONV_WIDTH]

kernel_name = "hybrid_dit_swa_shortconv_ecmoe"


def rmsnorm(x, g):
    xf = x.astype(jnp.float32)
    r = xf * lax.rsqrt(jnp.mean(xf * xf, axis=-1, keepdims=True) + EPS)
    return (r * g.astype(jnp.float32)).astype(x.dtype)


def modulate(h, shift, scale):
    return h * (1 + scale) + shift


def axial_rope_tables(seq_len):
    rows = seq_len // GRID_W
    row = jnp.repeat(jnp.arange(rows), GRID_W, total_repeat_length=rows * GRID_W)
    col = jnp.tile(jnp.arange(GRID_W), rows)
    n_freq = HEAD_DIM // 4
    inv = ROPE_THETA ** (-jnp.arange(n_freq, dtype=jnp.float32) / n_freq)
    ang = jnp.concatenate([row.astype(jnp.float32)[:, None] * inv,
                           col.astype(jnp.float32)[:, None] * inv], axis=-1)
    return jnp.cos(ang), jnp.sin(ang)


def apply_rope(x, cos, sin):
    xf = x.astype(jnp.float32)
    half = HEAD_DIM // 2
    x1, x2 = xf[..., :half], xf[..., half:]
    cs, sn = cos[None, :, None, :], sin[None, :, None, :]
    return jnp.concatenate([x1 * cs - x2 * sn, x1 * sn + x2 * cs], axis=-1).astype(x.dtype)


def windowed_attention(q, k, v, k_ctx, v_ctx, sink):
    bsz, seq, _, hd = q.shape
    nb = seq // BLOCK
    scale = hd ** -0.5
    qb = q.reshape(bsz, nb, BLOCK, N_KV_HEADS, GQA_GROUP, hd)
    pad = ((0, 0), (BLOCK, BLOCK), (0, 0), (0, 0))
    kp = jnp.pad(k, pad).reshape(bsz, nb + 2, BLOCK, N_KV_HEADS, hd)
    vp = jnp.pad(v, pad).reshape(bsz, nb + 2, BLOCK, N_KV_HEADS, hd)
    kb = jnp.concatenate([kp[:, :-2], kp[:, 1:-1], kp[:, 2:]], axis=2)
    vb = jnp.concatenate([vp[:, :-2], vp[:, 1:-1], vp[:, 2:]], axis=2)
    s_loc = jnp.einsum('bnqkgd,bnjkd->bnkgqj', qb, kb).astype(jnp.float32) * scale
    s_ctx = jnp.einsum('bnqkgd,bjkd->bnkgqj', qb, k_ctx).astype(jnp.float32) * scale
    i = jnp.arange(BLOCK)[None, :, None]
    j = jnp.arange(3 * BLOCK)[None, None, :]
    kpos = jnp.arange(nb)[:, None, None] * BLOCK + j - BLOCK
    valid = (jnp.abs(j - BLOCK - i) <= WINDOW) & (kpos >= 0) & (kpos < seq)
    s_loc = jnp.where(valid[None, :, None, None], s_loc, -jnp.inf)
    sk = jnp.broadcast_to(sink.astype(jnp.float32).reshape(N_KV_HEADS, GQA_GROUP)[None, None, :, :, None, None],
                          s_loc.shape[:-1] + (1,))
    p = jax.nn.softmax(jnp.concatenate([sk, s_ctx, s_loc], axis=-1), axis=-1)
    n_ctx = k_ctx.shape[1]
    p_ctx = p[..., 1:1 + n_ctx].astype(v.dtype)
    p_loc = p[..., 1 + n_ctx:].astype(v.dtype)
    out = (jnp.einsum('bnkgqj,bjkd->bnqkgd', p_ctx, v_ctx)
           + jnp.einsum('bnkgqj,bnjkd->bnqkgd', p_loc, vb))
    return out.reshape(bsz, seq, N_HEADS * hd)


def context_attention(q, k, v, sink):
    bsz, n, _, hd = q.shape
    qg = q.reshape(bsz, n, N_KV_HEADS, GQA_GROUP, hd)
    s = jnp.einsum('bqkgd,bjkd->bkgqj', qg, k).astype(jnp.float32) * hd ** -0.5
    sk = jnp.broadcast_to(sink.astype(jnp.float32).reshape(N_KV_HEADS, GQA_GROUP)[None, :, :, None, None],
                          s.shape[:-1] + (1,))
    p = jax.nn.softmax(jnp.concatenate([sk, s], axis=-1), axis=-1)[..., 1:].astype(v.dtype)
    return jnp.einsum('bkgqj,bjkd->bqkgd', p, v).reshape(bsz, n, N_HEADS * hd)


def short_conv_mixer(bg, cg, hv, conv_w):
    u = cg * hv
    up = jnp.pad(u, ((0, 0), (1, 1), (0, 0)))
    y = conv_w[0] * up[:, :-2] + conv_w[1] * up[:, 1:-1] + conv_w[2] * up[:, 2:]
    return bg * y


def expert_choice_ffn(h, w_router, w_gate, w_up, w_down):
    bsz, n, d = h.shape
    cap = EC_CAPACITY_FACTOR * n // N_EXPERTS
    aff = jax.nn.softmax((h @ w_router).astype(jnp.float32), axis=-1)
    g, idx = lax.top_k(jnp.swapaxes(aff, 1, 2), cap)
    xs = jax.vmap(lambda hb, ib: hb[ib])(h, idx)
    a = jnp.einsum('becd,edf->becf', xs, w_gate)
    u = jnp.einsum('becd,edf->becf', xs, w_up)
    y = jnp.einsum('becf,efd->becd', jax.nn.silu(a) * u, w_down) * g[..., None].astype(h.dtype)
    flat = (idx + (jnp.arange(bsz) * n)[:, None, None]).reshape(-1)
    out = jax.ops.segment_sum(y.reshape(-1, d), flat, num_segments=bsz * n)
    return out.reshape(bsz, n, d)


def setup_inputs(seed: int = 0) -> dict:
    key = jax.random.key(seed)
    ks = jax.random.split(key, 17)
    D = D_MODEL
    nrm = jax.random.normal
    f32 = jnp.float32
    return {
        "x": nrm(ks[0], (BATCH, SEQ, D), f32),
        "c": nrm(ks[1], (BATCH, D), f32),
        "ctx": nrm(ks[2], (BATCH, CTX_LEN, D), f32),
        "c_ctx": nrm(ks[3], (D,), f32),
        "w_ada": nrm(ks[4], (DEPTH, D, 6 * D), f32) * (0.5 * D ** -0.5),
        "b_ada": nrm(ks[5], (DEPTH, 6 * D), f32) * 0.01,
        "g_mix": 1.0 + 0.1 * nrm(ks[6], (DEPTH, D), f32),
        "w_in": nrm(ks[7], (DEPTH, D, IN_WIDTH), f32) * D ** -0.5,
        "conv_w": nrm(ks[8], (DEPTH, CONV_K, CONV_WIDTH), f32) * CONV_K ** -0.5,
        "sink": nrm(ks[9], (DEPTH, N_HEADS), f32),
        "w_out": nrm(ks[10], (DEPTH, D, D), f32) * D ** -0.5,
        "g_ffn": 1.0 + 0.1 * nrm(ks[11], (DEPTH, D), f32),
        "w_router": nrm(ks[12], (DEPTH, D, N_EXPERTS), f32) * D ** -0.5,
        "w_gate": nrm(ks[13], (DEPTH, N_EXPERTS, D, D_EXPERT), f32) * D ** -0.5,
        "w_up": nrm(ks[14], (DEPTH, N_EXPERTS, D, D_EXPERT), f32) * D ** -0.5,
        "w_down": nrm(ks[15], (DEPTH, N_EXPERTS, D_EXPERT, D), f32) * D_EXPERT ** -0.5,
        "g_final": 1.0 + 0.1 * nrm(ks[16], (D,), f32),
    }


def reference(x, c, ctx, c_ctx, w_ada, b_ada, g_mix, w_in, conv_w, sink, w_out, g_ffn,
              w_router, w_gate, w_up, w_down, g_final):
    bsz, seq, _ = x.shape
    cos, sin = axial_rope_tables(seq)
    for l in range(DEPTH):
        last = l == DEPTH - 1
        mod = jax.nn.silu(c) @ w_ada[l] + b_ada[l]
        sh1, sc1, gt1, sh2, sc2, gt2 = [m[:, None, :] for m in jnp.split(mod, 6, axis=-1)]
        mod_c = jax.nn.silu(c_ctx) @ w_ada[l] + b_ada[l]
        csh1, csc1, cgt1, csh2, csc2, cgt2 = jnp.split(mod_c, 6, axis=-1)

        hc = modulate(rmsnorm(ctx, g_mix[l]), csh1, csc1)
        n_ctx = ctx.shape[1]
        if last:
            kv_c = hc @ w_in[l][:, ATT_WIDTH:ATT_WIDTH + 2 * KV_WIDTH]
            k_c, v_c = jnp.split(kv_c, 2, axis=-1)
            k_c = k_c.reshape(bsz, n_ctx, N_KV_HEADS, HEAD_DIM)
            v_c = v_c.reshape(bsz, n_ctx, N_KV_HEADS, HEAD_DIM)
        else:
            q_c, k_c, v_c, bg_c, cg_c, hv_c = jnp.split(hc @ w_in[l], SPLIT_POINTS, axis=-1)
            q_c = q_c.reshape(bsz, n_ctx, N_HEADS, HEAD_DIM)
            k_c = k_c.reshape(bsz, n_ctx, N_KV_HEADS, HEAD_DIM)
            v_c = v_c.reshape(bsz, n_ctx, N_KV_HEADS, HEAD_DIM)
            att_c = context_attention(q_c, k_c, v_c, sink[l])
            conv_c = short_conv_mixer(bg_c, cg_c, hv_c, conv_w[l])
            ctx_new = ctx + cgt1 * (jnp.concatenate([att_c, conv_c], axis=-1) @ w_out[l])
            hc2 = modulate(rmsnorm(ctx_new, g_ffn[l]), csh2, csc2)
            ctx_new = ctx_new + cgt2 * expert_choice_ffn(hc2, w_router[l], w_gate[l], w_up[l], w_down[l])

        h = modulate(rmsnorm(x, g_mix[l]), sh1, sc1)
        q, k, v, bg, cg, hv = jnp.split(h @ w_in[l], SPLIT_POINTS, axis=-1)
        q = apply_rope(q.reshape(bsz, seq, N_HEADS, HEAD_DIM), cos, sin)
        k = apply_rope(k.reshape(bsz, seq, N_KV_HEADS, HEAD_DIM), cos, sin)
        v = v.reshape(bsz, seq, N_KV_HEADS, HEAD_DIM)
        att = windowed_attention(q, k, v, k_c, v_c, sink[l])
        conv = short_conv_mixer(bg, cg, hv, conv_w[l])
        x = x + gt1 * (jnp.concatenate([att, conv], axis=-1) @ w_out[l])

        h2 = modulate(rmsnorm(x, g_ffn[l]), sh2, sc2)
        x = x + gt2 * expert_choice_ffn(h2, w_router[l], w_gate[l], w_up[l], w_down[l])

        if not last:
            ctx = ctx_new
    return rmsnorm(x, g_final)
```

```cpp
#include <hip/hip_runtime.h>
#include <cstdio>
#include <cstdint>
namespace pg8 {
#define PG8_LAS __attribute__((address_space(3)))
typedef unsigned short bf16_t;
typedef short bf16x8 __attribute__((ext_vector_type(8)));
typedef float f32x4 __attribute__((ext_vector_type(4)));
typedef unsigned u32x4 __attribute__((ext_vector_type(4)));
constexpr int BM = 256, BK = 64, HALF = 128, HTB = HALF * BK * 2  , STAGE_BYTES = 8 * HTB, NXCD = 8, WGM = 8;

__host__ __device__ __forceinline__ int lds_byte(int r, int c) { const int st = (r >> 4) * 2 + (c >> 5), rr = r & 15, cc = c & 31, ob = rr * 64 + cc * 2; return st * 1024 + (ob ^ (((ob >> 9) & 1) << 5)); }
__host__ __device__ __forceinline__ void stage_rc(int b, int& R, int& C) { const int st = b / 1024, sb = b % 1024, swz = sb ^ (((sb >> 9) & 1) << 5); R = (st >> 1) * 16 + swz / 64; C = (st & 1) * 32 + (swz % 64) / 2; }
__host__ __device__ __forceinline__ int perm32(int rho) { const int n = rho >> 4, i = rho & 15; return 8 * (i >> 2) + 4 * n + (i & 3); }

struct Unit { int pm, pn; };
struct Gemm { const bf16_t* A; const bf16_t* Bt; int M, N, K; };

struct StaticOrder {
    int nM, nN, nwg, G, c;
    __host__ __device__ void init(int M, int N, int G_, int c_) { nM = M / BM; nN = N / BM; nwg = nM * nN; G = G_; c = c_; }
    __host__ __device__ bool next(int i, Unit& u) const {
        const long L = (long)i * G + c; if (L >= nwg) return false;
        int wgid = (int)L; { const int q = nwg / NXCD, r = nwg % NXCD, xcd = wgid % NXCD, off = wgid / NXCD; wgid = (xcd < r ? xcd * (q + 1) : r * (q + 1) + (xcd - r) * q) + off; }
        const int nig = WGM * nN, gid = wgid / nig, fm = gid * WGM, gsz = (nM - fm) < WGM ? (nM - fm) : WGM;
        u.pm = fm + ((wgid % nig) % gsz); u.pn = (wgid % nig) / gsz; return true;
    }
    __device__ __forceinline__ void a_ready(const Unit&) const {}
    __device__ __forceinline__ void done(const Unit&) const {}
};

__device__ __forceinline__ unsigned cvt_pk_bf16(float lo, float hi) { unsigned r; asm volatile("v_cvt_pk_bf16_f32 %0, %1, %2" : "=v"(r) : "v"(lo), "v"(hi)); return r; }
__device__ __forceinline__ int pg8_lane() { int l; asm volatile("v_mbcnt_lo_u32_b32 %0, -1, 0\n\tv_mbcnt_hi_u32_b32 %0, -1, %0" : "=v"(l)); return l; }
template <class Epi, class Sched, bool ALIGN_EPI = false, bool SP2 = false>
__device__ __forceinline__ void gemm_phase(PG8_LAS unsigned char* lds, const Gemm g, const Sched& S, const Epi& E, const int wave_id) {
    const int wid = wave_id, lane = pg8_lane(), tid = wid * 64 + lane, wr = wid >> 2, wc = wid & 3, fr = lane & 15, fq = lane >> 4;
    const int K = g.K, nt = K / BK;
    unsigned voffA[2], voffB[2];
#pragma unroll
    for (int i = 0; i < 2; ++i) { int R, C; stage_rc(tid * 16 + i * 8192, R, C); const int Rb = Epi::PERM ? ((R & ~31) + perm32(R & 31)) : R;
        voffA[i] = (unsigned)(R * K + C) * 2u; voffB[i] = (unsigned)(Rb * K + C) * 2u; }
    const size_t kstep = (size_t)(BK * 2);
    const size_t hstep = (size_t)HALF * K * 2;
    const size_t tstep = 2 * hstep;
    const unsigned ldsw = (unsigned)wid * 1024u;
    const int aoff = lds_byte(wr * 64 + fr, fq * 8), boff = lds_byte(wc * 32 + fr, fq * 8);
#define PG8_SA(b, h) (((b) * 2 + (h)) * HTB)
#define PG8_SB(b, h) ((4 + (b) * 2 + (h)) * HTB)
#define PG8_STAGE(bufoff, gbase, voff) do { _Pragma("unroll") for (int _i = 0; _i < 2; ++_i) \
        __builtin_amdgcn_global_load_lds((const unsigned*)((const char*)(gbase) + (voff)[_i]), (PG8_LAS unsigned*)(lds + (bufoff) + ldsw + _i * 8192), 16, 0, 0); } while (0)
#define PG8_LDA(dst, b, h) do { _Pragma("unroll") for (int m = 0; m < 4; ++m) _Pragma("unroll") for (int k = 0; k < 2; ++k) dst[m][k] = *(const PG8_LAS bf16x8*)(lds + PG8_SA(b, h) + aoff + m * 2048 + k * 1024); } while (0)
#define PG8_LDB(dst, b, h) do { _Pragma("unroll") for (int n = 0; n < 2; ++n) _Pragma("unroll") for (int k = 0; k < 2; ++k) dst[n][k] = *(const PG8_LAS bf16x8*)(lds + PG8_SB(b, h) + boff + n * 2048 + k * 1024); } while (0)
#define PG8_MMA(ai, bj, At, Bt) do { __builtin_amdgcn_s_setprio(1); _Pragma("unroll") for (int m = 0; m < 4; ++m) _Pragma("unroll") for (int n = 0; n < 2; ++n) _Pragma("unroll") for (int k = 0; k < 2; ++k) \
        acc[ai][bj][m][n] = __builtin_amdgcn_mfma_f32_16x16x32_bf16(Bt[n][k], At[m][k], acc[ai][bj][m][n], 0, 0, 0); __builtin_amdgcn_s_setprio(0); } while (0)
#define PG8_WAIT_V(n) asm volatile("s_waitcnt vmcnt(" #n ")" ::: "memory")
#define PG8_WAIT_L(n) asm volatile("s_waitcnt lgkmcnt(" #n ")" ::: "memory")
#define PG8_BAR __builtin_amdgcn_s_barrier()
#define PG8_SCHED __builtin_amdgcn_sched_barrier(0)
    Unit cur, nxt; int ui = 0;
    if (!S.next(0, cur)) return;
    f32x4 acc[2][2][4][2];
#pragma unroll
    for (int a = 0; a < 2; ++a)
#pragma unroll
        for (int b = 0; b < 2; ++b)
#pragma unroll
            for (int m = 0; m < 4; ++m)
#pragma unroll
                for (int n = 0; n < 2; ++n) acc[a][b][m][n] = (f32x4){0.f, 0.f, 0.f, 0.f};
    bf16x8 At[4][2], B0[2][2], B1[2][2];
    const char* cA = (const char*)g.A + (size_t)cur.pm * tstep; const char* cB = (const char*)g.Bt + (size_t)cur.pn * tstep;
    S.a_ready(cur);
    if constexpr (SP2) {
        PG8_STAGE(PG8_SB(0, 0), cB, voffB); PG8_STAGE(PG8_SB(0, 1), cB + hstep, voffB); PG8_STAGE(PG8_SA(0, 0), cA, voffA); PG8_STAGE(PG8_SA(0, 1), cA + hstep, voffA);
        if (wr == 1) PG8_BAR;
        PG8_WAIT_V(2); PG8_BAR;
        PG8_STAGE(PG8_SB(1, 0), cB + kstep, voffB); PG8_STAGE(PG8_SA(1, 0), cA + kstep, voffA); PG8_STAGE(PG8_SB(1, 1), cB + hstep + kstep, voffB);
        PG8_WAIT_V(6); PG8_BAR;
    } else {
        PG8_STAGE(PG8_SB(0, 0), cB, voffB); PG8_STAGE(PG8_SA(0, 0), cA, voffA); PG8_STAGE(PG8_SB(0, 1), cB + hstep, voffB); PG8_STAGE(PG8_SA(0, 1), cA + hstep, voffA);
        if (wr == 1) PG8_BAR;
        PG8_WAIT_V(4); PG8_BAR;
        PG8_STAGE(PG8_SB(1, 0), cB + kstep, voffB); PG8_STAGE(PG8_SA(1, 0), cA + kstep, voffA); PG8_STAGE(PG8_SB(1, 1), cB + hstep + kstep, voffB);
        PG8_WAIT_V(6); PG8_BAR;
    }
    for (;;) {
        const bool has_next = S.next(ui + 1, nxt);
        const char* nA = has_next ? (const char*)g.A + (size_t)nxt.pm * tstep : cA; const char* nB = has_next ? (const char*)g.Bt + (size_t)nxt.pn * tstep : cB;
        for (int t = 0; t < nt; t += 2) {
            const bool last = (t == nt - 2);
            const char* a1 = cA + (size_t)(t + 1) * kstep;
            const char* a2 = last ? nA : cA + (size_t)(t + 2) * kstep; const char* b2 = last ? nB : cB + (size_t)(t + 2) * kstep;
            const char* a3 = a2 + kstep; const char* b3 = b2 + kstep;
            if (last && has_next) S.a_ready(nxt);
            if constexpr (SP2) {
            PG8_LDB(B0, 0, 0); PG8_LDB(B1, 0, 1); PG8_SCHED; PG8_LDA(At, 0, 0); PG8_STAGE(PG8_SA(1, 1), a1 + hstep, voffA);
            PG8_WAIT_V(8); PG8_WAIT_L(0); PG8_BAR; PG8_MMA(0, 0, At, B0); PG8_MMA(0, 1, At, B1); PG8_BAR; PG8_SCHED;
            PG8_LDA(At, 0, 1); PG8_STAGE(PG8_SB(0, 0), b2, voffB); PG8_STAGE(PG8_SB(0, 1), b2 + hstep, voffB); PG8_STAGE(PG8_SA(0, 0), a2, voffA);
            PG8_WAIT_V(8); PG8_WAIT_L(0); PG8_BAR; PG8_MMA(1, 0, At, B0); PG8_MMA(1, 1, At, B1); PG8_BAR; PG8_SCHED;
            PG8_LDB(B0, 1, 0); PG8_LDB(B1, 1, 1); PG8_SCHED; PG8_LDA(At, 1, 0); PG8_STAGE(PG8_SA(0, 1), a2 + hstep, voffA);
            PG8_WAIT_V(8); PG8_WAIT_L(0); PG8_BAR; PG8_MMA(0, 0, At, B0); PG8_MMA(0, 1, At, B1); PG8_BAR; PG8_SCHED;
            PG8_LDA(At, 1, 1); PG8_STAGE(PG8_SB(1, 0), b3, voffB); PG8_STAGE(PG8_SB(1, 1), b3 + hstep, voffB); PG8_STAGE(PG8_SA(1, 0), a3, voffA);
            PG8_WAIT_V(8); PG8_WAIT_L(0); PG8_BAR; PG8_MMA(1, 0, At, B0); PG8_MMA(1, 1, At, B1); PG8_BAR; PG8_SCHED;
            } else {
            PG8_LDB(B0, 0, 0); PG8_SCHED; PG8_LDA(At, 0, 0); PG8_STAGE(PG8_SA(1, 1), a1 + hstep, voffA);
            PG8_WAIT_L(8); PG8_BAR; PG8_WAIT_L(0); PG8_MMA(0, 0, At, B0); PG8_BAR; PG8_SCHED;
            PG8_LDB(B1, 0, 1); PG8_STAGE(PG8_SB(0, 0), b2, voffB);
            PG8_BAR; PG8_WAIT_L(0); PG8_MMA(0, 1, At, B1); PG8_BAR;
            PG8_LDA(At, 0, 1); PG8_STAGE(PG8_SA(0, 0), a2, voffA);
            PG8_BAR; PG8_WAIT_L(0); PG8_MMA(1, 0, At, B0); PG8_BAR; PG8_SCHED;
            PG8_STAGE(PG8_SB(0, 1), b2 + hstep, voffB);
            PG8_WAIT_V(6); PG8_BAR; PG8_MMA(1, 1, At, B1); PG8_BAR;
            PG8_LDB(B0, 1, 0); PG8_SCHED; PG8_LDA(At, 1, 0); PG8_STAGE(PG8_SA(0, 1), a2 + hstep, voffA);
            PG8_WAIT_L(8); PG8_BAR; PG8_WAIT_L(0); PG8_MMA(0, 0, At, B0); PG8_BAR; PG8_SCHED;
            PG8_LDB(B1, 1, 1); PG8_STAGE(PG8_SB(1, 0), b3, voffB);
            PG8_BAR; PG8_WAIT_L(0); PG8_MMA(0, 1, At, B1); PG8_BAR;
            PG8_LDA(At, 1, 1); PG8_STAGE(PG8_SA(1, 0), a3, voffA);
            PG8_BAR; PG8_WAIT_L(0); PG8_MMA(1, 0, At, B0); PG8_BAR; PG8_SCHED;
            PG8_STAGE(PG8_SB(1, 1), b3 + hstep, voffB);
            PG8_WAIT_V(6); PG8_BAR; PG8_MMA(1, 1, At, B1); PG8_BAR;
            }
        }
        if constexpr (ALIGN_EPI) { if (wr == 0) PG8_BAR; }
        if constexpr (!Epi::AFTER_DRAIN) { E(acc, cur, wr, wc, fr, fq); S.done(cur); }
        if (!has_next) break;
#pragma unroll
        for (int a = 0; a < 2; ++a)
#pragma unroll
            for (int b = 0; b < 2; ++b)
#pragma unroll
                for (int m = 0; m < 4; ++m)
#pragma unroll
                    for (int n = 0; n < 2; ++n) acc[a][b][m][n] = (f32x4){0.f, 0.f, 0.f, 0.f};
        cur = nxt; cA = nA; cB = nB; ++ui;
        if constexpr (ALIGN_EPI) { if (wr == 1) PG8_BAR; }
    }
    PG8_WAIT_V(0);
    if constexpr (!ALIGN_EPI) { if (wr == 0) PG8_BAR; }
    PG8_BAR;
    if constexpr (Epi::AFTER_DRAIN) { E.fused(acc, cur, wr, wc, fr, fq, lds, wid, lane); S.done(cur); }
#undef PG8_SA
#undef PG8_SB
#undef PG8_STAGE
#undef PG8_LDA
#undef PG8_LDB
#undef PG8_MMA
#undef PG8_WAIT_V
#undef PG8_WAIT_L
#undef PG8_BAR
#undef PG8_SCHED
}
}

constexpr int BATCH = 2, SEQ = 8192, DM = 1024, MTOK = BATCH * SEQ, CTXL = 256, MCTX = BATCH * CTXL, MALL = MTOK + MCTX;
constexpr int NHEAD = 8, NKVH = 2, HDIM = 64, ATTW = 512, KVW = 128, CONVW = 512, INW = 2304;
constexpr int NEXP = 16, CAP = 1024, DEXP = 1024;
constexpr int KVROWS = CTXL + SEQ;
constexpr float EPS_RMS = 1e-6f;
constexpr float QSCALE = 0.125f * 1.4426950408889634f;

namespace pg8 {
typedef unsigned u32x2 __attribute__((ext_vector_type(2)));
__device__ __forceinline__ float bf2f(unsigned short h) { return __uint_as_float((unsigned)h << 16); }

struct InProjOrder {
    int G, c;
    __device__ bool next(int i, Unit& u) const {
        const int L = i * G + c; constexpr int nM = 64, nN = 9, nwg = nM * nN;
        if (L >= nwg + 2) return false;
        if (L >= nwg) { u.pm = 64 + (L - nwg); u.pn = 2; return true; }
        int wgid = L; { const int q = nwg / NXCD, r = nwg % NXCD, xcd = wgid % NXCD, off = wgid / NXCD; wgid = (xcd < r ? xcd * (q + 1) : r * (q + 1) + (xcd - r) * q) + off; }
        const int nig = WGM * nN, gid = wgid / nig, fm = gid * WGM, gsz = (nM - fm) < WGM ? (nM - fm) : WGM;
        u.pm = fm + ((wgid % nig) % gsz); u.pn = (wgid % nig) / gsz; return true;
    }
    __device__ __forceinline__ void a_ready(const Unit&) const {}
    __device__ __forceinline__ void done(const Unit&) const {}
};
template <int NPE> struct MoeOrder {
    int G, c;
    __device__ bool next(int i, Unit& u) const {
        const int L = i * G + c; constexpr int U = NEXP * 8 * NPE;
        if (L >= U) return false;
        const int id = (L % NXCD) * (U / NXCD) + L / NXCD;
        const int e = id / (8 * NPE), sub = id % (8 * NPE);
        u.pm = e * 8 + (sub & 7); u.pn = e * NPE + (sub >> 3); return true;
    }
    __device__ __forceinline__ void a_ready(const Unit&) const {}
    __device__ __forceinline__ void done(const Unit&) const {}
};

struct EpiInProj {
    static constexpr bool PERM = true, AFTER_DRAIN = false;
    bf16_t *Q, *Kb, *Vt, *BG; const float* cosT; const float* sinT;
    __device__ __forceinline__ void operator()(const f32x4 (&acc)[2][2][4][2], const Unit& u, int wr, int wc, int fr, int fq) const {
        const int row0 = u.pm * BM + wr * 64 + fr;
        if (u.pn >= 3) {
            bf16_t* base = BG + (size_t)((u.pn - 3) >> 1) * ((size_t)MTOK * CONVW);
            const int col0 = ((u.pn - 3) & 1) * 256 + wc * 32 + 8 * fq;
#pragma unroll
            for (int ai = 0; ai < 2; ++ai)
#pragma unroll
                for (int m = 0; m < 4; ++m) { bf16_t* rowp = base + (size_t)(row0 + ai * HALF + m * 16) * CONVW + col0;
#pragma unroll
                    for (int bj = 0; bj < 2; ++bj) { const f32x4 v0 = acc[ai][bj][m][0], v1 = acc[ai][bj][m][1];
                        u32x4 w; w.x = cvt_pk_bf16(v0[0], v0[1]); w.y = cvt_pk_bf16(v0[2], v0[3]); w.z = cvt_pk_bf16(v1[0], v1[1]); w.w = cvt_pk_bf16(v1[2], v1[3]);
                        *(u32x4*)(rowp + bj * HALF) = w; } }
        } else if (u.pn < 2) {
            const int dbase = 16 * (wc & 1) + 4 * fq;
#pragma unroll
            for (int ai = 0; ai < 2; ++ai)
#pragma unroll
                for (int m = 0; m < 4; ++m) { const int r = row0 + ai * HALF + m * 16, t = r & (SEQ - 1), pos = (wc & 1) ? (t & 63) : (t >> 6);
                    const f32x4 cs = *(const f32x4*)(cosT + pos * 16 + 4 * fq), sn = *(const f32x4*)(sinT + pos * 16 + 4 * fq);
#pragma unroll
                    for (int bj = 0; bj < 2; ++bj) { const f32x4 x1 = acc[ai][bj][m][0], x2 = acc[ai][bj][m][1];
                        const f32x4 o1 = (x1 * cs - x2 * sn) * QSCALE, o2 = (x1 * sn + x2 * cs) * QSCALE;
                        bf16_t* p = Q + (size_t)r * ATTW + (u.pn * 4 + bj * 2 + (wc >> 1)) * HDIM + dbase;
                        u32x2 a, b; a.x = cvt_pk_bf16(o1[0], o1[1]); a.y = cvt_pk_bf16(o1[2], o1[3]); b.x = cvt_pk_bf16(o2[0], o2[1]); b.y = cvt_pk_bf16(o2[2], o2[3]);
                        *(u32x2*)p = a; *(u32x2*)(p + 32) = b; }
                    asm volatile("" ::: "memory"); }
        } else {
            const bool is_ctx = u.pm >= MTOK / BM; const int dbase = 16 * (wc & 1) + 4 * fq, kvh = wc >> 1;
#pragma unroll
            for (int ai = 0; ai < 2; ++ai)
#pragma unroll
                for (int m = 0; m < 4; ++m) { const int r = row0 + ai * HALF + m * 16; int b, kvrow; f32x4 o1 = acc[ai][0][m][0], o2 = acc[ai][0][m][1];
                    if (!is_ctx) { b = r >> 13; const int t = r & (SEQ - 1), pos = (wc & 1) ? (t & 63) : (t >> 6); kvrow = CTXL + t;
                        const f32x4 cs = *(const f32x4*)(cosT + pos * 16 + 4 * fq), sn = *(const f32x4*)(sinT + pos * 16 + 4 * fq);
                        const f32x4 x1 = o1, x2 = o2; o1 = x1 * cs - x2 * sn; o2 = x1 * sn + x2 * cs; }
                    else { const int rr = r - MTOK; b = rr >> 8; kvrow = rr & (CTXL - 1); }
                    bf16_t* p = Kb + ((size_t)(b * NKVH + kvh) * KVROWS + kvrow) * HDIM + dbase;
                    u32x2 a, c2; a.x = cvt_pk_bf16(o1[0], o1[1]); a.y = cvt_pk_bf16(o1[2], o1[3]); c2.x = cvt_pk_bf16(o2[0], o2[1]); c2.y = cvt_pk_bf16(o2[2], o2[3]);
                    *(u32x2*)p = a; *(u32x2*)(p + 32) = c2;
                    bf16_t* vp = Vt + ((size_t)(b * NKVH + kvh) * HDIM + 32 * (wc & 1) + 8 * fq) * KVROWS + kvrow;
#pragma unroll
                    for (int n = 0; n < 2; ++n) { const f32x4 v = acc[ai][1][m][n]; const unsigned w0 = cvt_pk_bf16(v[0], v[1]), w1 = cvt_pk_bf16(v[2], v[3]);
                        vp[(size_t)(4 * n + 0) * KVROWS] = (bf16_t)(w0 & 0xffffu); vp[(size_t)(4 * n + 1) * KVROWS] = (bf16_t)(w0 >> 16);
                        vp[(size_t)(4 * n + 2) * KVROWS] = (bf16_t)(w1 & 0xffffu); vp[(size_t)(4 * n + 3) * KVROWS] = (bf16_t)(w1 >> 16); }
                    asm volatile("" ::: "memory"); }
        }
    }
};
struct EpiOutProj {
    static constexpr bool PERM = false, AFTER_DRAIN = false;
    const float* x; float* x1; const float* modf;
    __device__ __forceinline__ void operator()(const f32x4 (&acc)[2][2][4][2], const Unit& u, int wr, int wc, int fr, int fq) const {
        const int row0 = u.pm * BM + wr * 64 + fr, col0 = u.pn * BM + wc * 32 + 4 * fq, b = (u.pm * BM) >> 13;
        f32x4 gt[2][2];
#pragma unroll
        for (int bj = 0; bj < 2; ++bj)
#pragma unroll
            for (int n = 0; n < 2; ++n) gt[bj][n] = *(const f32x4*)(modf + (size_t)b * 6 * DM + 2 * DM + col0 + bj * HALF + n * 16);
#pragma unroll
        for (int ai = 0; ai < 2; ++ai)
#pragma unroll
            for (int m = 0; m < 4; ++m) { const size_t off = (size_t)(row0 + ai * HALF + m * 16) * DM + col0;
#pragma unroll
                for (int bj = 0; bj < 2; ++bj)
#pragma unroll
                    for (int n = 0; n < 2; ++n) { const f32x4 xv = *(const f32x4*)(x + off + bj * HALF + n * 16); *(f32x4*)(x1 + off + bj * HALF + n * 16) = xv + gt[bj][n] * acc[ai][bj][m][n]; } }
    }
};
struct EpiGateUp {
    static constexpr bool PERM = true, AFTER_DRAIN = false;
    bf16_t* act;
    __device__ __forceinline__ void operator()(const f32x4 (&acc)[2][2][4][2], const Unit& u, int wr, int wc, int fr, int fq) const {
        const int row0 = u.pm * BM + wr * 64 + fr, col0 = (u.pn & 7) * HALF + wc * 32 + 8 * fq;
#pragma unroll
        for (int ai = 0; ai < 2; ++ai)
#pragma unroll
            for (int m = 0; m < 4; ++m) { float o[8];
#pragma unroll
                for (int n = 0; n < 2; ++n)
#pragma unroll
                    for (int i = 0; i < 4; ++i) { const float g = acc[ai][0][m][n][i], up = acc[ai][1][m][n][i];
                        o[4 * n + i] = g * up * __builtin_amdgcn_rcpf(1.0f + __builtin_amdgcn_exp2f(-1.4426950408889634f * g)); }
                u32x4 w; w.x = cvt_pk_bf16(o[0], o[1]); w.y = cvt_pk_bf16(o[2], o[3]); w.z = cvt_pk_bf16(o[4], o[5]); w.w = cvt_pk_bf16(o[6], o[7]);
                *(u32x4*)(act + (size_t)(row0 + ai * HALF + m * 16) * DEXP + col0) = w; }
    }
};
struct EpiDown {
    static constexpr bool PERM = true, AFTER_DRAIN = false;
    bf16_t* y; const float* gsel;
    __device__ __forceinline__ void operator()(const f32x4 (&acc)[2][2][4][2], const Unit& u, int wr, int wc, int fr, int fq) const {
        const int row0 = u.pm * BM + wr * 64 + fr, col0 = (u.pn & 3) * BM + wc * 32 + 8 * fq;
#pragma unroll
        for (int ai = 0; ai < 2; ++ai)
#pragma unroll
            for (int m = 0; m < 4; ++m) { const int r = row0 + ai * HALF + m * 16; const float g = gsel[r];
#pragma unroll
                for (int bj = 0; bj < 2; ++bj) { const f32x4 v0 = acc[ai][bj][m][0] * g, v1 = acc[ai][bj][m][1] * g;
                    u32x4 w; w.x = cvt_pk_bf16(v0[0], v0[1]); w.y = cvt_pk_bf16(v0[2], v0[3]); w.z = cvt_pk_bf16(v1[0], v1[1]); w.w = cvt_pk_bf16(v1[2], v1[3]);
                    *(u32x4*)(y + (size_t)r * DM + col0 + bj * HALF) = w; } }
    }
};
}
#ifndef PG8_SP2
#define PG8_SP2 true
#endif
#ifndef PG8_ALIGN
#define PG8_ALIGN true
#endif

constexpr int NWAVES = 8;
constexpr int NPH = 10;
#ifndef MK_N_LAUNCHES
#define MK_N_LAUNCHES 1
#endif
constexpr int N_LAUNCHES = MK_N_LAUNCHES;
static_assert(N_LAUNCHES == 1 || N_LAUNCHES == NPH, "MK_N_LAUNCHES is 1 or 10");

constexpr size_t MiB = 1u << 20;
constexpr size_t WS_CTL = 0, CTL_ZERO_BYTES = 64 * 1024;
constexpr size_t WS_MODP = 1 * MiB;
constexpr size_t WS_MODF = 2 * MiB + 512 * 1024;
constexpr size_t WS_ROPE = 2 * MiB + 768 * 1024;
constexpr size_t WS_AFF = 3 * MiB;
constexpr size_t WS_GSEL = 4 * MiB;
constexpr size_t WS_SEL = 5 * MiB;
constexpr size_t WS_WIN = 6 * MiB, WS_WO = 11 * MiB;
constexpr size_t WS_WGU = 16 * MiB, WS_WD = 80 * MiB;
constexpr size_t WS_XN = 112 * MiB;
constexpr size_t WS_MIX = 112 * MiB;
constexpr size_t WS_H2 = 146 * MiB;
constexpr size_t WS_ACT = 112 * MiB;
constexpr size_t WS_Q = 178 * MiB, WS_K = 194 * MiB, WS_VT = 198 * MiB + 512 * 1024, WS_BG = 203 * MiB, WS_CG = 219 * MiB, WS_HV = 235 * MiB;
constexpr size_t WS_XS = 178 * MiB;
constexpr size_t WS_Y = 178 * MiB;
constexpr size_t WS_END = 251 * MiB;
static_assert(WS_K + (size_t)BATCH * NKVH * KVROWS * HDIM * 2 <= WS_VT && WS_VT + (size_t)BATCH * NKVH * KVROWS * HDIM * 2 <= WS_BG, "K / V^T buffers");
static_assert(WS_XN + (size_t)MALL * DM * 2 <= WS_H2 && WS_H2 + (size_t)MTOK * DM * 2 <= WS_Q && WS_XS + (size_t)NEXP * 2 * CAP * DM * 2 <= WS_END, "d_ws map");
constexpr int CW_BAR = 1024;
constexpr int RING_OFF = 0, RING_BYTES = 131072;
constexpr int LDSCTL_OFF = RING_BYTES, MISC_OFF = LDSCTL_OFF + 320;
constexpr int LDS_BYTES = 147456;

#define GAS __attribute__((address_space(1)))
#define LAS __attribute__((address_space(3)))
typedef unsigned short bf16;
typedef unsigned v4u __attribute__((ext_vector_type(4)));
typedef unsigned v2u __attribute__((ext_vector_type(2)));
typedef float f32x4 __attribute__((ext_vector_type(4)));
typedef float f32x16 __attribute__((ext_vector_type(16)));
typedef short bf16x8 __attribute__((ext_vector_type(8)));
typedef GAS unsigned gu32;
#define RLX_AGENT __ATOMIC_RELAXED, __HIP_MEMORY_SCOPE_AGENT
#define LDS_WAIT() asm volatile("s_waitcnt lgkmcnt(0)" ::: "memory")
#define VM_WAIT() asm volatile("s_waitcnt vmcnt(0)" ::: "memory")
__device__ __forceinline__ unsigned f2bf(float f) { unsigned u = __builtin_bit_cast(unsigned, f); return (u + 0x7fffu + ((u >> 16) & 1u)) >> 16; }
__device__ __forceinline__ unsigned pk2(float lo, float hi) { return f2bf(lo) | (f2bf(hi) << 16); }
__device__ __forceinline__ float bflo(unsigned w) { return __uint_as_float(w << 16); }
__device__ __forceinline__ float bfhi(unsigned w) { return __uint_as_float(w & 0xffff0000u); }
#define XB_TMO      128
#define XB_XCNT(j)  (256  + 64 * (j))
#define XB_XSUB(j)  (1280 + 64 * (j))
#define XB_XGEN(j)  (2304 + 64 * (j))
#define XB_TOP      3328
#define XB_TOPGEN   3392
#define XCD_BAR_WORDS 3456
#define XB_SPIN_CAP (1u << 18)

__device__ __forceinline__ unsigned xb_ld(unsigned* p)              { return __hip_atomic_load(p, __ATOMIC_RELAXED, __HIP_MEMORY_SCOPE_AGENT); }
__device__ __forceinline__ unsigned xb_add(unsigned* p, unsigned v) { return __hip_atomic_fetch_add(p, v, __ATOMIC_RELAXED, __HIP_MEMORY_SCOPE_AGENT); }
__device__ __forceinline__ unsigned xb_xcc_id() { return (unsigned)__builtin_amdgcn_s_getreg((3 << 11) | 20) & 0xFu; }
#define XB_SPIN(cond, bar) do { unsigned _sp = 0; while (cond) { __builtin_amdgcn_s_sleep(1); \
    if ((++_sp & 255u) == 0u) { if (xb_ld(&(bar)[XB_TMO])) break; if (_sp > XB_SPIN_CAP) { atomicAdd(&(bar)[XB_TMO], 1u); break; } } } } while (0)

struct XcdBarrier {
    unsigned* bar; unsigned x;
    volatile LAS unsigned* st;
    int w;
};

__device__ __forceinline__ int xb_lane() { int l; asm volatile("v_mbcnt_lo_u32_b32 %0, -1, 0\n\tv_mbcnt_hi_u32_b32 %0, -1, %0" : "=v"(l)); return l; }
#define MY_TID0() (b.w == 0 && xb_lane() == 0)
__device__ __forceinline__ XcdBarrier xcd_barrier_post(unsigned* bar, volatile LAS unsigned* st, int w) {
    XcdBarrier b; b.bar = bar; b.x = xb_xcc_id(); b.st = st; b.w = w;
    if (MY_TID0()) (void)xb_add(&bar[XB_XCNT(b.x)], 1u);
    return b;
}
__device__ __forceinline__ void xcd_barrier_complete(unsigned* bar, unsigned x, unsigned& nloc, unsigned& nx) {
    const unsigned G = gridDim.x * gridDim.y * gridDim.z;
    unsigned sum, cnt, mine, sp = 0u;
    for (;;) {
        sum = 0u; cnt = 0u; mine = 0u;
#pragma unroll
        for (unsigned j = 0; j < 16; ++j) { const unsigned c = xb_ld(&bar[XB_XCNT(j)]); sum += c; cnt += (c > 0u) ? 1u : 0u; mine = (j == x) ? c : mine; }
        if (sum == G) break;
        __builtin_amdgcn_s_sleep(1);
        if ((++sp & 255u) == 0u) { if (xb_ld(&bar[XB_TMO])) break; if (sp > XB_SPIN_CAP) { atomicAdd(&bar[XB_TMO], 1u); break; } }
    }
    nloc = mine > 0u ? mine : 1u; nx = cnt > 0u ? cnt : 1u;
}

__device__ __forceinline__ void xcd_barrier(const XcdBarrier& b) {
    asm volatile("s_waitcnt vmcnt(0)" ::: "memory");
    __syncthreads();
    if (MY_TID0()) {
        unsigned* bar = b.bar;
        __builtin_amdgcn_s_waitcnt(0);
        unsigned nloc = b.st[0], nx = b.st[1];
        if (nloc == 0u) { xcd_barrier_complete(bar, b.x, nloc, nx); b.st[0] = nloc; b.st[1] = nx; }
        const unsigned old = xb_add(&bar[XB_XSUB(b.x)], 1u);
        const unsigned gen = old / nloc;
        if (old + 1u == (gen + 1u) * nloc) {
            __builtin_amdgcn_fence(__ATOMIC_RELEASE, "agent");
            asm volatile("s_waitcnt vmcnt(0)" ::: "memory");
            const unsigned og = xb_add(&bar[XB_TOP], 1u);
            const unsigned tg = og / nx;
            if (og + 1u == (tg + 1u) * nx) xb_add(&bar[XB_TOPGEN], 1u);
            else XB_SPIN(xb_ld(&bar[XB_TOPGEN]) == tg, bar);
            __builtin_amdgcn_fence(__ATOMIC_ACQUIRE, "agent");
            xb_add(&bar[XB_XGEN(b.x)], 1u);
            asm volatile("s_waitcnt vmcnt(0)" ::: "memory");
        } else {
            XB_SPIN(xb_ld(&bar[XB_XGEN(b.x)]) == gen, bar);
            __builtin_amdgcn_fence(__ATOMIC_ACQUIRE, "agent");
            asm volatile("s_waitcnt vmcnt(0)" ::: "memory");
        }
    }
    __syncthreads();
}

__device__ __forceinline__ int lane_id() { int l; asm volatile("v_mbcnt_lo_u32_b32 %0, -1, 0\n\tv_mbcnt_hi_u32_b32 %0, -1, %0" : "=v"(l)); return l; }
struct Frame {
    LAS unsigned char* lds;
    volatile LAS unsigned* MISC;
    gu32* ctl;
    int wave, vcu, G;
    const float *x, *c, *ctx, *c_ctx, *w_ada, *b_ada, *g_mix, *w_in, *conv_w, *sink, *w_out, *g_ffn, *w_router, *w_gate, *w_up, *w_down, *g_final;
    float* out; unsigned char* ws;
};
__device__ __forceinline__ int ftid(const Frame& F) { return F.wave * 64 + lane_id(); }
__device__ __forceinline__ float wave_sum(float v) {
#pragma unroll
    for (int o = 1; o < 64; o <<= 1) v += __shfl_xor(v, o);
    return v;
}
typedef float f32x2_t __attribute__((ext_vector_type(2))); typedef __bf16 bf16x2_t __attribute__((ext_vector_type(2)));
__device__ __forceinline__ unsigned cvtpk(float lo, float hi) { f32x2_t v = {lo, hi}; bf16x2_t b = __builtin_convertvector(v, bf16x2_t); return __builtin_bit_cast(unsigned, b); }

template <int MODE> __device__ __forceinline__ int wt_row(int n, int row_off) {
    if (MODE == 0) return row_off + n;
    if (MODE == 1) { if (n >= ATTW + KVW) return n; const int d = n & 63; return (n & ~63) + 8 * ((d & 31) >> 2) + 4 * (d >> 5) + (d & 3); }
    return row_off + (n >> 7) * 256 + (n & 127) + (MODE == 3 ? 128 : 0);
}
template <int MODE> __device__ __forceinline__ void p0_transpose_item(const float* W, int K, int N, bf16* WT, int row_off, LAS float* scr, int item, int lane) {
    const int nblk = N / 32, kb = item / nblk, nb = item % nblk, k0 = 64 * kb, n0 = 32 * nb;
#pragma unroll 8
    for (int i = 0; i < 32; ++i) { const int kk = 2 * i + (lane >> 5); scr[kk * 33 + (lane & 31)] = W[(size_t)(k0 + kk) * N + n0 + (lane & 31)]; }
    LDS_WAIT(); asm volatile("" ::: "memory");
    const int c = lane & 7;
#pragma unroll
    for (int j = 0; j < 4; ++j) { const int n = (lane >> 3) + 8 * j; const LAS float* s = scr + (8 * c) * 33 + n;
        v4u o; o.x = pk2(s[0 * 33], s[1 * 33]); o.y = pk2(s[2 * 33], s[3 * 33]); o.z = pk2(s[4 * 33], s[5 * 33]); o.w = pk2(s[6 * 33], s[7 * 33]);
        *(GAS v4u*)(WT + (size_t)wt_row<MODE>(n0 + n, row_off) * K + k0 + 8 * c) = o; }
    LDS_WAIT(); asm volatile("" ::: "memory");
}
__device__ __forceinline__ void p0_prologue(Frame& F) {
    const int lane = lane_id(), tid = F.wave * 64 + lane;
    LAS float* sil = (LAS float*)(F.lds + LDSCTL_OFF + 1024);
    float* MODP = (float*)(F.ws + WS_MODP);
    for (int task = F.vcu; task < 192; task += F.G) {
        const int kc = task / 12, jb = task % 12;
        __syncthreads();
        if (tid < 192) { const int v = tid >> 6, k = kc * 64 + (tid & 63); const float cv = (v < 2) ? F.c[v * DM + k] : F.c_ctx[k]; sil[tid] = cv / (1.0f + __expf(-cv)); }
        __syncthreads();
        const int j = jb * 512 + tid; const float* wp = F.w_ada + (size_t)(kc * 64) * (6 * DM) + j; float a0 = 0.f, a1 = 0.f, a2 = 0.f;
#pragma unroll 16
        for (int kk = 0; kk < 64; ++kk) { const float w = wp[(size_t)kk * (6 * DM)]; a0 += sil[kk] * w; a1 += sil[64 + kk] * w; a2 += sil[128 + kk] * w; }
        MODP[(size_t)(kc * 3 + 0) * (6 * DM) + j] = a0; MODP[(size_t)(kc * 3 + 1) * (6 * DM) + j] = a1; MODP[(size_t)(kc * 3 + 2) * (6 * DM) + j] = a2;
    }
    if (F.vcu == (192 % F.G)) {
        float* cosT = (float*)(F.ws + WS_ROPE); float* sinT = cosT + 128 * 16;
        for (int i = tid; i < 2048; i += NWAVES * 64) { const int pos = i >> 4, f = i & 15;
            const double b4 = (f & 3) == 0 ? 1.0 : ((f & 3) == 1 ? 0.5623413251903491 : ((f & 3) == 2 ? 0.31622776601683794 : 0.1778279410038923));
            const double p10 = (f >> 2) == 0 ? 1.0 : ((f >> 2) == 1 ? 0.1 : ((f >> 2) == 2 ? 0.01 : 0.001));
            const double ang = (double)pos * (b4 * p10); const double kq = __builtin_rint(ang * 0.6366197723675814);
            const double r = (ang - kq * 1.5707963267948966) - kq * 6.123233995736766e-17; const int q = ((int)kq) & 3; const double r2 = r * r;
            const double s = r * (1.0 + r2 * (-1.0 / 6 + r2 * (1.0 / 120 + r2 * (-1.0 / 5040 + r2 * (1.0 / 362880 + r2 * (-1.0 / 39916800 + r2 * (1.0 / 6227020800.0)))))));
            const double c = 1.0 + r2 * (-0.5 + r2 * (1.0 / 24 + r2 * (-1.0 / 720 + r2 * (1.0 / 40320 + r2 * (-1.0 / 3628800 + r2 * (1.0 / 479001600.0 + r2 * (-1.0 / 87178291200.0)))))));
            const double cc = q == 0 ? c : (q == 1 ? -s : (q == 2 ? -c : s)), ss = q == 0 ? s : (q == 1 ? c : (q == 2 ? -s : -c));
            cosT[i] = (float)cc; sinT[i] = (float)ss; }
    }
    __syncthreads();
    LAS float* scr = (LAS float*)(F.lds + RING_OFF + F.wave * 16384);
    const int gw = F.vcu * NWAVES + F.wave, NGW = F.G * NWAVES;
    constexpr int I_IN = (DM / 64) * (INW / 32), I_O = (DM / 64) * (DM / 32), I_E = (DM / 64) * (DEXP / 32);
    constexpr int NITEMS = I_IN + I_O + 3 * NEXP * I_E;
    bf16* WIN = (bf16*)(F.ws + WS_WIN); bf16* WO = (bf16*)(F.ws + WS_WO); bf16* WGU = (bf16*)(F.ws + WS_WGU); bf16* WD = (bf16*)(F.ws + WS_WD);
    for (int it = gw; it < NITEMS; it += NGW) {
        int r = it;
        if (r < I_IN) { p0_transpose_item<1>(F.w_in, DM, INW, WIN, 0, scr, r, lane); continue; } r -= I_IN;
        if (r < I_O) { p0_transpose_item<0>(F.w_out, DM, DM, WO, 0, scr, r, lane); continue; } r -= I_O;
        const int mat = r / (NEXP * I_E), rr = r % (NEXP * I_E), e = rr / I_E, ie = rr % I_E;
        if (mat == 0) p0_transpose_item<2>(F.w_gate + (size_t)e * DM * DEXP, DM, DEXP, WGU, e * 2 * DEXP, scr, ie, lane);
        else if (mat == 1) p0_transpose_item<3>(F.w_up + (size_t)e * DM * DEXP, DM, DEXP, WGU, e * 2 * DEXP, scr, ie, lane);
        else p0_transpose_item<0>(F.w_down + (size_t)e * DEXP * DM, DEXP, DM, WD, e * DM, scr, ie, lane);
    }
}

__device__ __forceinline__ float mod_sum(const float* MODP, const float* b_ada, int v, int col) {
    float s = b_ada[col];
#pragma unroll
    for (int kc = 0; kc < 16; ++kc) s += MODP[(size_t)(kc * 3 + v) * (6 * DM) + col];
    return s;
}
__device__ __forceinline__ void p1_norm(Frame& F) {
    const int lane = lane_id(), tid = F.wave * 64 + lane;
    const float* MODP = (const float*)(F.ws + WS_MODP); float* MODF = (float*)(F.ws + WS_MODF);
    LAS float* tA = (LAS float*)(F.lds); LAS float* tB = tA + 3 * DM;
    for (int idx = tid; idx < 3 * 2 * DM; idx += NWAVES * 64) { const int v = idx / (2 * DM), q = idx % (2 * DM); const float s = mod_sum(MODP, F.b_ada, v, q);
        if (q < DM) tB[v * DM + q] = s; else tA[v * DM + q - DM] = F.g_mix[q - DM] * (1.0f + s); }
    for (int o = F.vcu * (NWAVES * 64) + tid; o < 3 * 6 * DM; o += F.G * NWAVES * 64) MODF[o] = mod_sum(MODP, F.b_ada, o / (6 * DM), o % (6 * DM));
    __syncthreads();
    bf16* XN = (bf16*)(F.ws + WS_XN);
    const int gw = F.vcu * NWAVES + F.wave, NGW = F.G * NWAVES;
    for (int m = gw; m < MALL; m += NGW) {
        const int v = m < SEQ ? 0 : (m < MTOK ? 1 : 2);
        const float* src = m < MTOK ? F.x + (size_t)m * DM : F.ctx + (size_t)(m - MTOK) * DM;
        const GAS f32x4* xr = (const GAS f32x4*)src + lane;
        f32x4 xv[4]; float ss = 0.f;
#pragma unroll
        for (int j = 0; j < 4; ++j) { xv[j] = xr[64 * j]; ss += (xv[j].x * xv[j].x + xv[j].y * xv[j].y) + (xv[j].z * xv[j].z + xv[j].w * xv[j].w); }
        const float rstd = 1.0f / sqrtf(wave_sum(ss) * (1.0f / DM) + EPS_RMS);
        GAS unsigned long long* o8 = (GAS unsigned long long*)(XN + (size_t)m * DM) + lane;
#pragma unroll
        for (int j = 0; j < 4; ++j) { const f32x4 a = *(const LAS f32x4*)(tA + v * DM + 4 * lane + 256 * j), sh = *(const LAS f32x4*)(tB + v * DM + 4 * lane + 256 * j);
            const f32x4 h = xv[j] * rstd * a + sh;
            o8[64 * j] = (unsigned long long)cvtpk(h.x, h.y) | ((unsigned long long)cvtpk(h.z, h.w) << 32); }
    }
}

#define MFMA32(a, b, c) __builtin_amdgcn_mfma_f32_32x32x16_bf16((a), (b), (c), 0, 0, 0)
__device__ __forceinline__ int crow(int r, int hi) { return (r & 3) + 8 * (r >> 2) + 4 * hi; }
__device__ __forceinline__ bf16x8 pack8(const f32x16& p, int s) {
    v4u w; w.x = cvtpk(p[8 * s + 0], p[8 * s + 1]); w.y = cvtpk(p[8 * s + 2], p[8 * s + 3]); w.z = cvtpk(p[8 * s + 4], p[8 * s + 5]); w.w = cvtpk(p[8 * s + 6], p[8 * s + 7]);
    return __builtin_bit_cast(bf16x8, w);
}
__device__ __forceinline__ void attn_unit(Frame& F, int u) {
    const int b = u >> 7, kvh = (u >> 6) & 1, n = u & 63;
    const int lane = lane_id(), r32 = lane & 31, hh = lane >> 5, g = F.wave >> 1, half = F.wave & 1, h = kvh * 4 + g;
    const bf16* Q = (const bf16*)(F.ws + WS_Q); bf16* MIX = (bf16*)(F.ws + WS_MIX);
    const bf16* Kbase = (const bf16*)(F.ws + WS_K) + (size_t)(b * NKVH + kvh) * KVROWS * HDIM;
    const bf16* Vbase = (const bf16*)(F.ws + WS_VT) + (size_t)(b * NKVH + kvh) * HDIM * KVROWS;
    const float sk2 = F.sink[h] * 1.4426950408889634f;
    const int q0 = n * 128 + half * 64;
    bf16x8 qf[2][4];
#pragma unroll
    for (int sb = 0; sb < 2; ++sb)
#pragma unroll
        for (int s = 0; s < 4; ++s) qf[sb][s] = *(const bf16x8*)(Q + (size_t)(b * SEQ + q0 + sb * 32 + r32) * ATTW + h * HDIM + 16 * s + 8 * hh);
    f32x16 o[2][2]; float mrun[2], lrun[2];
#pragma unroll
    for (int sb = 0; sb < 2; ++sb) { mrun[sb] = sk2; lrun[sb] = hh == 0 ? 1.0f : 0.0f;
#pragma unroll
        for (int db = 0; db < 2; ++db)
#pragma unroll
            for (int i = 0; i < 16; ++i) o[sb][db][i] = 0.f; }
    for (int tile = 0; tile < 10; ++tile) {
        int krow0, kpos0 = 0; const bool local = tile >= 4;
        if (!local) krow0 = tile * 64;
        else { kpos0 = n * 128 - 128 + (tile - 4) * 64; if (kpos0 < 0 || kpos0 >= SEQ) continue; krow0 = CTXL + kpos0; }
        bf16x8 kf[2][4], vf[2][4];
#pragma unroll
        for (int kb = 0; kb < 2; ++kb)
#pragma unroll
            for (int s = 0; s < 4; ++s) kf[kb][s] = *(const bf16x8*)(Kbase + (size_t)(krow0 + kb * 32 + r32) * HDIM + 16 * s + 8 * hh);
#pragma unroll
        for (int db = 0; db < 2; ++db)
#pragma unroll
            for (int ks = 0; ks < 4; ++ks) { const bf16* vp = Vbase + (size_t)(db * 32 + r32) * KVROWS + krow0 + 16 * ks + 4 * hh;
                const v2u lo = *(const v2u*)vp, hi = *(const v2u*)(vp + 8); v4u w; w.x = lo.x; w.y = lo.y; w.z = hi.x; w.w = hi.y; vf[db][ks] = __builtin_bit_cast(bf16x8, w); }
        const bool needmask = local && (tile < 6 || tile >= 8);
#pragma unroll
        for (int sb = 0; sb < 2; ++sb) {
            f32x16 p0, p1;
#pragma unroll
            for (int i = 0; i < 16; ++i) { p0[i] = 0.f; p1[i] = 0.f; }
#pragma unroll
            for (int s = 0; s < 4; ++s) { p0 = MFMA32(kf[0][s], qf[sb][s], p0); p1 = MFMA32(kf[1][s], qf[sb][s], p1); }
            if (needmask) { const int qpos = q0 + sb * 32 + r32;
#pragma unroll
                for (int i = 0; i < 16; ++i) { const int dk = kpos0 + crow(i, hh) - qpos; if (dk > 128 || dk < -128) p0[i] = -1e30f; if (dk + 32 > 128 || dk + 32 < -128) p1[i] = -1e30f; } }
            float mx = fmaxf(p0[0], p1[0]);
#pragma unroll
            for (int i = 1; i < 16; ++i) mx = fmaxf(mx, fmaxf(p0[i], p1[i]));
            mx = fmaxf(mx, __shfl_xor(mx, 32));
            const float mnew = fmaxf(mrun[sb], mx), alpha = __builtin_amdgcn_exp2f(mrun[sb] - mnew); mrun[sb] = mnew;
            float ps = 0.f;
#pragma unroll
            for (int i = 0; i < 16; ++i) { p0[i] = __builtin_amdgcn_exp2f(p0[i] - mnew); p1[i] = __builtin_amdgcn_exp2f(p1[i] - mnew); ps += p0[i] + p1[i]; }
            lrun[sb] = lrun[sb] * alpha + ps;
#pragma unroll
            for (int db = 0; db < 2; ++db)
#pragma unroll
                for (int i = 0; i < 16; ++i) o[sb][db][i] *= alpha;
            bf16x8 pb[4]; pb[0] = pack8(p0, 0); pb[1] = pack8(p0, 1); pb[2] = pack8(p1, 0); pb[3] = pack8(p1, 1);
#pragma unroll
            for (int db = 0; db < 2; ++db)
#pragma unroll
                for (int ks = 0; ks < 4; ++ks) o[sb][db] = MFMA32(vf[db][ks], pb[ks], o[sb][db]);
        }
    }
#pragma unroll
    for (int sb = 0; sb < 2; ++sb) { const float lt = lrun[sb] + __shfl_xor(lrun[sb], 32), inv = 1.0f / lt;
        bf16* dst = MIX + (size_t)(b * SEQ + q0 + sb * 32 + r32) * DM + h * HDIM;
#pragma unroll
        for (int db = 0; db < 2; ++db)
#pragma unroll
            for (int g4 = 0; g4 < 4; ++g4) { v2u w; w.x = cvtpk(o[sb][db][4 * g4] * inv, o[sb][db][4 * g4 + 1] * inv); w.y = cvtpk(o[sb][db][4 * g4 + 2] * inv, o[sb][db][4 * g4 + 3] * inv);
                *(v2u*)(dst + db * 32 + 8 * g4 + 4 * hh) = w; } }
}
__device__ __forceinline__ void unpack8(const v4u w, float (&f)[8]) { f[0] = bflo(w.x); f[1] = bfhi(w.x); f[2] = bflo(w.y); f[3] = bfhi(w.y); f[4] = bflo(w.z); f[5] = bfhi(w.z); f[6] = bflo(w.w); f[7] = bfhi(w.w); }
__device__ __forceinline__ void p3_attn_conv(Frame& F) {
    const int tid = F.wave * 64 + lane_id();
    for (int u = F.vcu; u < BATCH * NKVH * (SEQ / 128); u += F.G) attn_unit(F, u);
    const bf16* BG = (const bf16*)(F.ws + WS_BG); const bf16* CG = (const bf16*)(F.ws + WS_CG); const bf16* HV = (const bf16*)(F.ws + WS_HV); bf16* MIX = (bf16*)(F.ws + WS_MIX);
    for (int idx = F.vcu * (NWAVES * 64) + tid; idx < MTOK * (CONVW / 8); idx += F.G * NWAVES * 64) {
        const int row = idx >> 6, c8 = (idx & 63) * 8, t = row & (SEQ - 1); const size_t off = (size_t)row * CONVW + c8;
        float bgv[8], uc[8], up[8], un[8], a[8], bq[8];
        unpack8(*(const v4u*)(BG + off), bgv);
        unpack8(*(const v4u*)(CG + off), a); unpack8(*(const v4u*)(HV + off), bq);
#pragma unroll
        for (int i = 0; i < 8; ++i) uc[i] = a[i] * bq[i];
        if (t > 0) { unpack8(*(const v4u*)(CG + off - CONVW), a); unpack8(*(const v4u*)(HV + off - CONVW), bq);
#pragma unroll
            for (int i = 0; i < 8; ++i) up[i] = a[i] * bq[i]; }
        else {
#pragma unroll
            for (int i = 0; i < 8; ++i) up[i] = 0.f; }
        if (t < SEQ - 1) { unpack8(*(const v4u*)(CG + off + CONVW), a); unpack8(*(const v4u*)(HV + off + CONVW), bq);
#pragma unroll
            for (int i = 0; i < 8; ++i) un[i] = a[i] * bq[i]; }
        else {
#pragma unroll
            for (int i = 0; i < 8; ++i) un[i] = 0.f; }
        float r[8];
#pragma unroll
        for (int i = 0; i < 8; ++i) r[i] = bgv[i] * (F.conv_w[c8 + i] * up[i] + F.conv_w[CONVW + c8 + i] * uc[i] + F.conv_w[2 * CONVW + c8 + i] * un[i]);
        v4u w; w.x = cvtpk(r[0], r[1]); w.y = cvtpk(r[2], r[3]); w.z = cvtpk(r[4], r[5]); w.w = cvtpk(r[6], r[7]);
        *(v4u*)(MIX + (size_t)row * DM + ATTW + c8) = w;
    }
}

__device__ __forceinline__ void p5_norm_router(Frame& F) {
    const int lane = lane_id(), tid = F.wave * 64 + lane;
    const float* MODF = (const float*)(F.ws + WS_MODF);
    LAS float* wr = (LAS float*)(F.lds);
    LAS float* tA = wr + NEXP * DM; LAS float* tB = tA + 2 * DM;
    for (int i = tid; i < NEXP * DM; i += NWAVES * 64) { const int k = i >> 4, e = i & 15; wr[e * DM + k] = F.w_router[i]; }
    for (int i = tid; i < 2 * DM; i += NWAVES * 64) { const int b = i >> 10, k = i & (DM - 1);
        tA[i] = F.g_ffn[k] * (1.0f + MODF[(size_t)b * 6 * DM + 4 * DM + k]); tB[i] = MODF[(size_t)b * 6 * DM + 3 * DM + k]; }
    __syncthreads();
    bf16* H2 = (bf16*)(F.ws + WS_H2); float* AFF = (float*)(F.ws + WS_AFF);
    const int gw = F.vcu * NWAVES + F.wave, NGW = F.G * NWAVES;
    for (int m = gw; m < MTOK; m += NGW) {
        const int b = m >> 13, t = m & (SEQ - 1);
        const GAS f32x4* xr = (const GAS f32x4*)(F.out + (size_t)m * DM) + lane;
        f32x4 hv[4]; float ss = 0.f;
#pragma unroll
        for (int j = 0; j < 4; ++j) { hv[j] = xr[64 * j]; ss += (hv[j].x * hv[j].x + hv[j].y * hv[j].y) + (hv[j].z * hv[j].z + hv[j].w * hv[j].w); }
        const float rstd = 1.0f / sqrtf(wave_sum(ss) * (1.0f / DM) + EPS_RMS);
        GAS unsigned long long* o8 = (GAS unsigned long long*)(H2 + (size_t)m * DM) + lane;
#pragma unroll
        for (int j = 0; j < 4; ++j) { const f32x4 a = *(const LAS f32x4*)(tA + b * DM + 4 * lane + 256 * j), sh = *(const LAS f32x4*)(tB + b * DM + 4 * lane + 256 * j);
            hv[j] = hv[j] * rstd * a + sh;
            o8[64 * j] = (unsigned long long)cvtpk(hv[j].x, hv[j].y) | ((unsigned long long)cvtpk(hv[j].z, hv[j].w) << 32); }
        float mylg = 0.f;
#pragma unroll 1
        for (int e = 0; e < NEXP; ++e) { float s = 0.f;
#pragma unroll
            for (int j = 0; j < 4; ++j) { const f32x4 w = *(const LAS f32x4*)(wr + e * DM + 4 * lane + 256 * j); s += (hv[j].x * w.x + hv[j].y * w.y) + (hv[j].z * w.z + hv[j].w * w.w); }
            s = wave_sum(s); mylg = ((lane & 15) == e) ? s : mylg; }
        float mx = mylg;
#pragma unroll
        for (int o = 1; o < 16; o <<= 1) mx = fmaxf(mx, __shfl_xor(mx, o));
        const float ex = __expf(mylg - mx); float den = ex;
#pragma unroll
        for (int o = 1; o < 16; o <<= 1) den += __shfl_xor(den, o);
        const float mine = ex / den;
        if (lane < NEXP) AFF[(size_t)(b * NEXP + lane) * SEQ + t] = mine;
    }
}

__device__ __forceinline__ int block_excl_scan(int v, LAS int* wsum, int lane, int wave, int& total) {
    int x = v;
#pragma unroll
    for (int o = 1; o < 64; o <<= 1) { const int y = __shfl_up(x, o); if (lane >= o) x += y; }
    if (lane == 63) wsum[wave] = x;
    __syncthreads();
    int base = 0, tot = 0;
#pragma unroll
    for (int w = 0; w < NWAVES; ++w) { const int s = wsum[w]; base += (w < wave) ? s : 0; tot += s; }
    __syncthreads();
    total = tot; return base + x - v;
}
__device__ __forceinline__ void p6_topk_task(Frame& F, int task) {
    const int b = task >> 7, e = (task >> 3) & 15, part = task & 7, lane = lane_id(), tid = F.wave * 64 + lane;
    LAS unsigned* keys = (LAS unsigned*)(F.lds);
    LAS unsigned* hist = (LAS unsigned*)(F.lds + 32768);
    LAS int* misc = (LAS int*)(F.lds + 32768 + 1024);
    LAS int* list = (LAS int*)(F.lds + 36864);
    const float* aff = (const float*)(F.ws + WS_AFF) + (size_t)(b * NEXP + e) * SEQ;
    __syncthreads();
    for (int i = tid; i < SEQ / 4; i += NWAVES * 64) *(LAS v4u*)(keys + 4 * i) = *(const v4u*)(aff + 4 * i);
    __syncthreads();
    unsigned prefix = 0u, mask = 0u; int kk = CAP;
    for (int pass = 3; pass >= 0; --pass) {
        if (tid < 256) hist[tid] = 0u;
        __syncthreads();
        const int sh = pass * 8;
#pragma unroll 4
        for (int j = 0; j < 16; ++j) { const unsigned k = keys[tid + 512 * j]; if ((k & mask) == prefix) __hip_atomic_fetch_add(hist + ((k >> sh) & 255u), 1u, __ATOMIC_RELAXED, __HIP_MEMORY_SCOPE_WORKGROUP); }
        __syncthreads();
        if (F.wave == 0) {
            const int c0 = (int)hist[255 - 4 * lane], c1 = (int)hist[254 - 4 * lane], c2 = (int)hist[253 - 4 * lane], c3 = (int)hist[252 - 4 * lane];
            const int s = c0 + c1 + c2 + c3; int incl = s;
#pragma unroll
            for (int o = 1; o < 64; o <<= 1) { const int y = __shfl_up(incl, o); if (lane >= o) incl += y; }
            const int excl = incl - s;
            if (excl < kk && incl >= kk) { const int r = kk - excl; int bin, above;
                if (r <= c0) { bin = 255 - 4 * lane; above = 0; } else if (r <= c0 + c1) { bin = 254 - 4 * lane; above = c0; }
                else if (r <= c0 + c1 + c2) { bin = 253 - 4 * lane; above = c0 + c1; } else { bin = 252 - 4 * lane; above = c0 + c1 + c2; }
                misc[0] = bin; misc[1] = r - above; }
        }
        __syncthreads();
        prefix |= (unsigned)misc[0] << sh; mask |= 255u << sh; kk = misc[1];
        __syncthreads();
    }
    const unsigned thr = prefix; const int need = kk;
    const int t0 = part * (SEQ / 8);
    int cgt = 0, ceq = 0;
#pragma unroll 4
    for (int j = 0; j < 16; ++j) { const int i = tid + 512 * j; const unsigned k = keys[i]; if (i < t0) { cgt += (k > thr) ? 1 : 0; ceq += (k == thr) ? 1 : 0; } }
    int gt_before, eq_before;
    (void)block_excl_scan(cgt, misc + 16, lane, F.wave, gt_before);
    (void)block_excl_scan(ceq, misc + 16, lane, F.wave, eq_before);
    const int tA = t0 + 2 * tid; const unsigned kA = keys[tA], kB = keys[tA + 1];
    const int eqA = (kA == thr) ? 1 : 0, eqB = (kB == thr) ? 1 : 0; int dummy;
    const int eqx = block_excl_scan(eqA + eqB, misc + 16, lane, F.wave, dummy);
    const int eposA = eq_before + eqx, eposB = eposA + eqA;
    const int selA = (kA > thr || (eqA && eposA < need)) ? 1 : 0, selB = (kB > thr || (eqB && eposB < need)) ? 1 : 0;
    int nloc;
    const int sx = block_excl_scan(selA + selB, misc + 16, lane, F.wave, nloc);
    const int sel_before = gt_before + (eq_before < need ? eq_before : need);
    int* SEL = (int*)(F.ws + WS_SEL); float* GSEL = (float*)(F.ws + WS_GSEL);
    const int slotA = sel_before + sx, slotB = slotA + selA; const size_t eb = (size_t)(e * 2 + b) * CAP;
    SEL[(size_t)(b * SEQ + tA) * NEXP + e] = selA ? slotA : -1; SEL[(size_t)(b * SEQ + tA + 1) * NEXP + e] = selB ? slotB : -1;
    if (selA) { GSEL[eb + slotA] = __uint_as_float(kA); list[sx] = tA; }
    if (selB) { GSEL[eb + slotB] = __uint_as_float(kB); list[sx + selA] = tA + 1; }
    __syncthreads();
    const bf16* H2 = (const bf16*)(F.ws + WS_H2); bf16* XS = (bf16*)(F.ws + WS_XS);
    for (int r = F.wave; r < nloc; r += NWAVES) { const int tok = list[r];
        const v4u* src = (const v4u*)(H2 + (size_t)(b * SEQ + tok) * DM); v4u* dst = (v4u*)(XS + (eb + sel_before + r) * DM);
        const v4u a = src[lane], c = src[lane + 64]; dst[lane] = a; dst[lane + 64] = c; }
}

__device__ __forceinline__ void p9_final(Frame& F) {
    const int lane = lane_id();
    const float* MODF = (const float*)(F.ws + WS_MODF); const int* SEL = (const int*)(F.ws + WS_SEL); const bf16* Y = (const bf16*)(F.ws + WS_Y);
    const int gw = F.vcu * NWAVES + F.wave, NGW = F.G * NWAVES;
    for (int m = gw; m < MTOK; m += NGW) {
        const int b = m >> 13;
        GAS f32x4* xr = (GAS f32x4*)(F.out + (size_t)m * DM) + lane;
        f32x4 xv[4], acc[4];
#pragma unroll
        for (int j = 0; j < 4; ++j) { xv[j] = xr[64 * j]; acc[j] = (f32x4){0.f, 0.f, 0.f, 0.f}; }
        const int selv = (lane < NEXP) ? SEL[(size_t)m * NEXP + lane] : -1;
#pragma unroll
        for (int e = 0; e < NEXP; ++e) { const int s = __builtin_amdgcn_readlane(selv, e);
            if (s >= 0) { const GAS v2u* yr = (const GAS v2u*)(Y + ((size_t)(e * 2 + b) * CAP + s) * DM) + lane;
#pragma unroll
                for (int j = 0; j < 4; ++j) { const v2u w = yr[64 * j]; acc[j].x += bflo(w.x); acc[j].y += bfhi(w.x); acc[j].z += bflo(w.y); acc[j].w += bfhi(w.y); } } }
        float ss = 0.f;
#pragma unroll
        for (int j = 0; j < 4; ++j) { const f32x4 gt = *(const f32x4*)(MODF + (size_t)b * 6 * DM + 5 * DM + 4 * lane + 256 * j);
            xv[j] = xv[j] + gt * acc[j]; ss += (xv[j].x * xv[j].x + xv[j].y * xv[j].y) + (xv[j].z * xv[j].z + xv[j].w * xv[j].w); }
        const float rstd = 1.0f / sqrtf(wave_sum(ss) * (1.0f / DM) + EPS_RMS);
#pragma unroll
        for (int j = 0; j < 4; ++j) { const f32x4 gf = *(const f32x4*)(F.g_final + 4 * lane + 256 * j); xr[64 * j] = xv[j] * rstd * gf; }
    }
}

struct Args { const float* in[17]; float* out; unsigned char* ws; int ph_lo, ph_hi; };
__global__ void __launch_bounds__(NWAVES * 64, 2) dit_fwd(Args args) {
    extern __shared__ __attribute__((aligned(16))) unsigned char lds[];
    Frame F;
    F.lds = (LAS unsigned char*)lds;
    F.MISC = (volatile LAS unsigned*)(F.lds + MISC_OFF);
    F.wave = __builtin_amdgcn_readfirstlane((int)threadIdx.x >> 6);
    F.G = gridDim.x; { const int bx = blockIdx.x; F.vcu = (F.G % 8 == 0) ? (bx % 8) * (F.G / 8) + bx / 8 : bx; }
    F.ws = args.ws; F.out = args.out; F.ctl = (gu32*)(args.ws + WS_CTL);
    F.x = args.in[0]; F.c = args.in[1]; F.ctx = args.in[2]; F.c_ctx = args.in[3]; F.w_ada = args.in[4]; F.b_ada = args.in[5]; F.g_mix = args.in[6]; F.w_in = args.in[7];
    F.conv_w = args.in[8]; F.sink = args.in[9]; F.w_out = args.in[10]; F.g_ffn = args.in[11]; F.w_router = args.in[12]; F.w_gate = args.in[13]; F.w_up = args.in[14];
    F.w_down = args.in[15]; F.g_final = args.in[16];
    for (int u = ftid(F); u < (LDS_BYTES - LDSCTL_OFF) / 4; u += NWAVES * 64) ((LAS unsigned*)(F.lds + LDSCTL_OFF))[u] = 0u;
    __syncthreads();
    XcdBarrier bar; bar.bar = (unsigned*)(F.ctl + CW_BAR); bar.x = 0; bar.st = nullptr; bar.w = F.wave;
    if (N_LAUNCHES == 1) bar = xcd_barrier_post((unsigned*)(F.ctl + CW_BAR), F.MISC + 8, F.wave);
    const int lo = args.ph_lo, hi = args.ph_hi;
#ifdef DBG_ONLY
#define IN(k) ((k) == DBG_ONLY && lo <= (k) && (k) < hi)
#else
#define IN(k) (lo <= (k) && (k) < hi)
#endif
#define SEAM(k) do { if (IN(k) && IN((k) + 1)) xcd_barrier(bar); } while (0)

    if (IN(0)) { p0_prologue(F); SEAM(0); }
    if (IN(1)) { p1_norm(F); SEAM(1); }
    if (IN(2)) {
        pg8::Gemm g{(const pg8::bf16_t*)(F.ws + WS_XN), (const pg8::bf16_t*)(F.ws + WS_WIN), MALL, INW, DM};
        pg8::InProjOrder S{F.G, (int)blockIdx.x};
        const float* cosT = (const float*)(F.ws + WS_ROPE);
        pg8::EpiInProj E{(pg8::bf16_t*)(F.ws + WS_Q), (pg8::bf16_t*)(F.ws + WS_K), (pg8::bf16_t*)(F.ws + WS_VT), (pg8::bf16_t*)(F.ws + WS_BG), cosT, cosT + 128 * 16};
        static_assert(WS_CG == WS_BG + (size_t)MTOK * CONVW * 2 && WS_HV == WS_CG + (size_t)MTOK * CONVW * 2, "bg | cg | hv contiguous");
        pg8::gemm_phase<pg8::EpiInProj, pg8::InProjOrder, PG8_ALIGN, PG8_SP2>(F.lds + RING_OFF, g, S, E, F.wave);
        SEAM(2);
    }
    if (IN(3)) { p3_attn_conv(F); SEAM(3); }
    if (IN(4)) {
        pg8::Gemm g{(const pg8::bf16_t*)(F.ws + WS_MIX), (const pg8::bf16_t*)(F.ws + WS_WO), MTOK, DM, DM};
        pg8::StaticOrder S; S.init(MTOK, DM, F.G, (int)blockIdx.x);
        pg8::EpiOutProj E{F.x, F.out, (const float*)(F.ws + WS_MODF)};
        pg8::gemm_phase<pg8::EpiOutProj, pg8::StaticOrder, PG8_ALIGN, PG8_SP2>(F.lds + RING_OFF, g, S, E, F.wave);
        SEAM(4);
    }
    if (IN(5)) { p5_norm_router(F); SEAM(5); }
    if (IN(6)) { for (int task = F.vcu; task < BATCH * NEXP * 8; task += F.G) p6_topk_task(F, task); SEAM(6); }
    if (IN(7)) {
        pg8::Gemm g{(const pg8::bf16_t*)(F.ws + WS_XS), (const pg8::bf16_t*)(F.ws + WS_WGU), NEXP * 2 * CAP, NEXP * 2 * DEXP, DM};
        pg8::MoeOrder<8> S{F.G, (int)blockIdx.x};
        pg8::EpiGateUp E{(pg8::bf16_t*)(F.ws + WS_ACT)};
        pg8::gemm_phase<pg8::EpiGateUp, pg8::MoeOrder<8>, PG8_ALIGN, PG8_SP2>(F.lds + RING_OFF, g, S, E, F.wave);
        SEAM(7);
    }
    if (IN(8)) {
        pg8::Gemm g{(const pg8::bf16_t*)(F.ws + WS_ACT), (const pg8::bf16_t*)(F.ws + WS_WD), NEXP * 2 * CAP, NEXP * DM, DEXP};
        pg8::MoeOrder<4> S{F.G, (int)blockIdx.x};
        pg8::EpiDown E{(pg8::bf16_t*)(F.ws + WS_Y), (const float*)(F.ws + WS_GSEL)};
        pg8::gemm_phase<pg8::EpiDown, pg8::MoeOrder<4>, PG8_ALIGN, PG8_SP2>(F.lds + RING_OFF, g, S, E, F.wave);
        SEAM(8);
    }
    if (IN(9)) { p9_final(F); }
#undef IN
#undef SEAM
}

extern "C" void kernel_launch(void* const* d_in, const int* in_sizes, int n_in, void* d_out, int out_size, void* d_ws, size_t ws_size, hipStream_t stream) {
    static int grid = 0;
    if (grid == 0) {
        if (n_in != 17 || in_sizes[0] != MTOK * DM || out_size != MTOK * DM || ws_size < WS_END) { fprintf(stderr, "kernel_launch: unexpected shapes (n_in %d, in0 %d, out %d, ws %zu); nothing launched\n", n_in, n_in > 0 ? in_sizes[0] : -1, out_size, ws_size); grid = -1; return; }
        int dev = 0, cus = 0, per_cu = 0;
        if (hipGetDevice(&dev) != hipSuccess || hipDeviceGetAttribute(&cus, hipDeviceAttributeMultiprocessorCount, dev) != hipSuccess) { fprintf(stderr, "kernel_launch: device query failed\n"); grid = -1; return; }
        if (hipFuncSetAttribute((const void*)dit_fwd, hipFuncAttributeMaxDynamicSharedMemorySize, LDS_BYTES) != hipSuccess) { fprintf(stderr, "kernel_launch: hipFuncSetAttribute failed\n"); grid = -1; return; }
        if (hipOccupancyMaxActiveBlocksPerMultiprocessor(&per_cu, (const void*)dit_fwd, NWAVES * 64, LDS_BYTES) != hipSuccess || per_cu < 1) { fprintf(stderr, "kernel_launch: occupancy query reports %d workgroups per CU\n", per_cu); per_cu = 1; }
        (void)hipGetLastError();
        grid = cus;
    }
    if (grid < 0) return;
    (void)hipMemsetAsync((char*)d_ws + WS_CTL, 0, CTL_ZERO_BYTES, stream);
    Args a{};
    for (int i = 0; i < 17; ++i) a.in[i] = (const float*)d_in[i];
    a.out = (float*)d_out; a.ws = (unsigned char*)d_ws;
    if (N_LAUNCHES == 1) { a.ph_lo = 0; a.ph_hi = NPH; hipLaunchKernelGGL(dit_fwd, dim3(grid), dim3(NWAVES * 64), LDS_BYTES, stream, a); }
    else for (int li = 0; li < NPH; ++li) { a.ph_lo = li; a.ph_hi = li + 1; hipLaunchKernelGGL(dit_fwd, dim3(grid), dim3(NWAVES * 64), LDS_BYTES, stream, a); }
}
```

```cpp
#include <hip/hip_runtime.h>
#include <cstdio>
#include <cstdint>
namespace pg8 {
#define PG8_LAS __attribute__((address_space(3)))
typedef unsigned short bf16_t;
typedef short bf16x8 __attribute__((ext_vector_type(8)));
typedef float f32x4 __attribute__((ext_vector_type(4)));
typedef unsigned u32x4 __attribute__((ext_vector_type(4)));
constexpr int BM = 256, BK = 64, HALF = 128, HTB = HALF * BK * 2  , STAGE_BYTES = 8 * HTB, NXCD = 8, WGM = 8;

__host__ __device__ __forceinline__ int lds_byte(int r, int c) { const int st = (r >> 4) * 2 + (c >> 5), rr = r & 15, cc = c & 31, ob = rr * 64 + cc * 2; return st * 1024 + (ob ^ (((ob >> 9) & 1) << 5)); }
__host__ __device__ __forceinline__ void stage_rc(int b, int& R, int& C) { const int st = b / 1024, sb = b % 1024, swz = sb ^ (((sb >> 9) & 1) << 5); R = (st >> 1) * 16 + swz / 64; C = (st & 1) * 32 + (swz % 64) / 2; }
__host__ __device__ __forceinline__ int perm32(int rho) { const int n = rho >> 4, i = rho & 15; return 8 * (i >> 2) + 4 * n + (i & 3); }

struct Unit { int pm, pn; };
struct Gemm { const bf16_t* A; const bf16_t* Bt; int M, N, K; };

struct StaticOrder {
    int nM, nN, nwg, G, c;
    __host__ __device__ void init(int M, int N, int G_, int c_) { nM = M / BM; nN = N / BM; nwg = nM * nN; G = G_; c = c_; }
    __host__ __device__ bool next(int i, Unit& u) const {
        const long L = (long)i * G + c; if (L >= nwg) return false;
        int wgid = (int)L; { const int q = nwg / NXCD, r = nwg % NXCD, xcd = wgid % NXCD, off = wgid / NXCD; wgid = (xcd < r ? xcd * (q + 1) : r * (q + 1) + (xcd - r) * q) + off; }
        const int nig = WGM * nN, gid = wgid / nig, fm = gid * WGM, gsz = (nM - fm) < WGM ? (nM - fm) : WGM;
        u.pm = fm + ((wgid % nig) % gsz); u.pn = (wgid % nig) / gsz; return true;
    }
    __device__ __forceinline__ void a_ready(const Unit&) const {}
    __device__ __forceinline__ void done(const Unit&) const {}
};

__device__ __forceinline__ unsigned cvt_pk_bf16(float lo, float hi) { unsigned r; asm volatile("v_cvt_pk_bf16_f32 %0, %1, %2" : "=v"(r) : "v"(lo), "v"(hi)); return r; }
__device__ __forceinline__ int pg8_lane() { int l; asm volatile("v_mbcnt_lo_u32_b32 %0, -1, 0\n\tv_mbcnt_hi_u32_b32 %0, -1, %0" : "=v"(l)); return l; }
template <class Epi, class Sched, bool ALIGN_EPI = false, bool SP2 = false>
__device__ __forceinline__ void gemm_phase(PG8_LAS unsigned char* lds, const Gemm g, const Sched& S, const Epi& E, const int wave_id) {
    const int wid = wave_id, lane = pg8_lane(), tid = wid * 64 + lane, wr = wid >> 2, wc = wid & 3, fr = lane & 15, fq = lane >> 4;
    const int K = g.K, nt = K / BK;
    unsigned voffA[2], voffB[2];
#pragma unroll
    for (int i = 0; i < 2; ++i) { int R, C; stage_rc(tid * 16 + i * 8192, R, C); const int Rb = Epi::PERM ? ((R & ~31) + perm32(R & 31)) : R;
        voffA[i] = (unsigned)(R * K + C) * 2u; voffB[i] = (unsigned)(Rb * K + C) * 2u; }
    const size_t kstep = (size_t)(BK * 2);
    const size_t hstep = (size_t)HALF * K * 2;
    const size_t tstep = 2 * hstep;
    const unsigned ldsw = (unsigned)wid * 1024u;
    const int aoff = lds_byte(wr * 64 + fr, fq * 8), boff = lds_byte(wc * 32 + fr, fq * 8);
#define PG8_SA(b, h) (((b) * 2 + (h)) * HTB)
#define PG8_SB(b, h) ((4 + (b) * 2 + (h)) * HTB)
#define PG8_STAGE(bufoff, gbase, voff) do { _Pragma("unroll") for (int _i = 0; _i < 2; ++_i) \
        __builtin_amdgcn_global_load_lds((const unsigned*)((const char*)(gbase) + (voff)[_i]), (PG8_LAS unsigned*)(lds + (bufoff) + ldsw + _i * 8192), 16, 0, 0); } while (0)
#define PG8_LDA(dst, b, h) do { _Pragma("unroll") for (int m = 0; m < 4; ++m) _Pragma("unroll") for (int k = 0; k < 2; ++k) dst[m][k] = *(const PG8_LAS bf16x8*)(lds + PG8_SA(b, h) + aoff + m * 2048 + k * 1024); } while (0)
#define PG8_LDB(dst, b, h) do { _Pragma("unroll") for (int n = 0; n < 2; ++n) _Pragma("unroll") for (int k = 0; k < 2; ++k) dst[n][k] = *(const PG8_LAS bf16x8*)(lds + PG8_SB(b, h) + boff + n * 2048 + k * 1024); } while (0)
#define PG8_MMA(ai, bj, At, Bt) do { __builtin_amdgcn_s_setprio(1); _Pragma("unroll") for (int m = 0; m < 4; ++m) _Pragma("unroll") for (int n = 0; n < 2; ++n) _Pragma("unroll") for (int k = 0; k < 2; ++k) \
        acc[ai][bj][m][n] = __builtin_amdgcn_mfma_f32_16x16x32_bf16(Bt[n][k], At[m][k], acc[ai][bj][m][n], 0, 0, 0); __builtin_amdgcn_s_setprio(0); } while (0)
#define PG8_WAIT_V(n) asm volatile("s_waitcnt vmcnt(" #n ")" ::: "memory")
#define PG8_WAIT_L(n) asm volatile("s_waitcnt lgkmcnt(" #n ")" ::: "memory")
#define PG8_BAR __builtin_amdgcn_s_barrier()
#define PG8_SCHED __builtin_amdgcn_sched_barrier(0)
    Unit cur, nxt; int ui = 0;
    if (!S.next(0, cur)) return;
    f32x4 acc[2][2][4][2];
#pragma unroll
    for (int a = 0; a < 2; ++a)
#pragma unroll
        for (int b = 0; b < 2; ++b)
#pragma unroll
            for (int m = 0; m < 4; ++m)
#pragma unroll
                for (int n = 0; n < 2; ++n) acc[a][b][m][n] = (f32x4){0.f, 0.f, 0.f, 0.f};
    bf16x8 At[4][2], B0[2][2], B1[2][2];
    const char* cA = (const char*)g.A + (size_t)cur.pm * tstep; const char* cB = (const char*)g.Bt + (size_t)cur.pn * tstep;
    S.a_ready(cur);
    if constexpr (SP2) {
        PG8_STAGE(PG8_SB(0, 0), cB, voffB); PG8_STAGE(PG8_SB(0, 1), cB + hstep, voffB); PG8_STAGE(PG8_SA(0, 0), cA, voffA); PG8_STAGE(PG8_SA(0, 1), cA + hstep, voffA);
        if (wr == 1) PG8_BAR;
        PG8_WAIT_V(2); PG8_BAR;
        PG8_STAGE(PG8_SB(1, 0), cB + kstep, voffB); PG8_STAGE(PG8_SA(1, 0), cA + kstep, voffA); PG8_STAGE(PG8_SB(1, 1), cB + hstep + kstep, voffB);
        PG8_WAIT_V(6); PG8_BAR;
    } else {
        PG8_STAGE(PG8_SB(0, 0), cB, voffB); PG8_STAGE(PG8_SA(0, 0), cA, voffA); PG8_STAGE(PG8_SB(0, 1), cB + hstep, voffB); PG8_STAGE(PG8_SA(0, 1), cA + hstep, voffA);
        if (wr == 1) PG8_BAR;
        PG8_WAIT_V(4); PG8_BAR;
        PG8_STAGE(PG8_SB(1, 0), cB + kstep, voffB); PG8_STAGE(PG8_SA(1, 0), cA + kstep, voffA); PG8_STAGE(PG8_SB(1, 1), cB + hstep + kstep, voffB);
        PG8_WAIT_V(6); PG8_BAR;
    }
    for (;;) {
        const bool has_next = S.next(ui + 1, nxt);
        const char* nA = has_next ? (const char*)g.A + (size_t)nxt.pm * tstep : cA; const char* nB = has_next ? (const char*)g.Bt + (size_t)nxt.pn * tstep : cB;
        for (int t = 0; t < nt; t += 2) {
            const bool last = (t == nt - 2);
            const char* a1 = cA + (size_t)(t + 1) * kstep;
            const char* a2 = last ? nA : cA + (size_t)(t + 2) * kstep; const char* b2 = last ? nB : cB + (size_t)(t + 2) * kstep;
            const char* a3 = a2 + kstep; const char* b3 = b2 + kstep;
            if (last && has_next) S.a_ready(nxt);
            if constexpr (SP2) {
            PG8_LDB(B0, 0, 0); PG8_LDB(B1, 0, 1); PG8_SCHED; PG8_LDA(At, 0, 0); PG8_STAGE(PG8_SA(1, 1), a1 + hstep, voffA);
            PG8_WAIT_V(8); PG8_WAIT_L(0); PG8_BAR; PG8_MMA(0, 0, At, B0); PG8_MMA(0, 1, At, B1); PG8_BAR; PG8_SCHED;
            PG8_LDA(At, 0, 1); PG8_STAGE(PG8_SB(0, 0), b2, voffB); PG8_STAGE(PG8_SB(0, 1), b2 + hstep, voffB); PG8_STAGE(PG8_SA(0, 0), a2, voffA);
            PG8_WAIT_V(8); PG8_WAIT_L(0); PG8_BAR; PG8_MMA(1, 0, At, B0); PG8_MMA(1, 1, At, B1); PG8_BAR; PG8_SCHED;
            PG8_LDB(B0, 1, 0); PG8_LDB(B1, 1, 1); PG8_SCHED; PG8_LDA(At, 1, 0); PG8_STAGE(PG8_SA(0, 1), a2 + hstep, voffA);
            PG8_WAIT_V(8); PG8_WAIT_L(0); PG8_BAR; PG8_MMA(0, 0, At, B0); PG8_MMA(0, 1, At, B1); PG8_BAR; PG8_SCHED;
            PG8_LDA(At, 1, 1); PG8_STAGE(PG8_SB(1, 0), b3, voffB); PG8_STAGE(PG8_SB(1, 1), b3 + hstep, voffB); PG8_STAGE(PG8_SA(1, 0), a3, voffA);
            PG8_WAIT_V(8); PG8_WAIT_L(0); PG8_BAR; PG8_MMA(1, 0, At, B0); PG8_MMA(1, 1, At, B1); PG8_BAR; PG8_SCHED;
            } else {
            PG8_LDB(B0, 0, 0); PG8_SCHED; PG8_LDA(At, 0, 0); PG8_STAGE(PG8_SA(1, 1), a1 + hstep, voffA);
            PG8_WAIT_L(8); PG8_BAR; PG8_WAIT_L(0); PG8_MMA(0, 0, At, B0); PG8_BAR; PG8_SCHED;
            PG8_LDB(B1, 0, 1); PG8_STAGE(PG8_SB(0, 0), b2, voffB);
            PG8_BAR; PG8_WAIT_L(0); PG8_MMA(0, 1, At, B1); PG8_BAR;
            PG8_LDA(At, 0, 1); PG8_STAGE(PG8_SA(0, 0), a2, voffA);
            PG8_BAR; PG8_WAIT_L(0); PG8_MMA(1, 0, At, B0); PG8_BAR; PG8_SCHED;
            PG8_STAGE(PG8_SB(0, 1), b2 + hstep, voffB);
            PG8_WAIT_V(6); PG8_BAR; PG8_MMA(1, 1, At, B1); PG8_BAR;
            PG8_LDB(B0, 1, 0); PG8_SCHED; PG8_LDA(At, 1, 0); PG8_STAGE(PG8_SA(0, 1), a2 + hstep, voffA);
            PG8_WAIT_L(8); PG8_BAR; PG8_WAIT_L(0); PG8_MMA(0, 0, At, B0); PG8_BAR; PG8_SCHED;
            PG8_LDB(B1, 1, 1); PG8_STAGE(PG8_SB(1, 0), b3, voffB);
            PG8_BAR; PG8_WAIT_L(0); PG8_MMA(0, 1, At, B1); PG8_BAR;
            PG8_LDA(At, 1, 1); PG8_STAGE(PG8_SA(1, 0), a3, voffA);
            PG8_BAR; PG8_WAIT_L(0); PG8_MMA(1, 0, At, B0); PG8_BAR; PG8_SCHED;
            PG8_STAGE(PG8_SB(1, 1), b3 + hstep, voffB);
            PG8_WAIT_V(6); PG8_BAR; PG8_MMA(1, 1, At, B1); PG8_BAR;
            }
        }
        if constexpr (ALIGN_EPI) { if (wr == 0) PG8_BAR; }
        if constexpr (!Epi::AFTER_DRAIN) { E(acc, cur, wr, wc, fr, fq); S.done(cur); }
        if (!has_next) break;
#pragma unroll
        for (int a = 0; a < 2; ++a)
#pragma unroll
            for (int b = 0; b < 2; ++b)
#pragma unroll
                for (int m = 0; m < 4; ++m)
#pragma unroll
                    for (int n = 0; n < 2; ++n) acc[a][b][m][n] = (f32x4){0.f, 0.f, 0.f, 0.f};
        cur = nxt; cA = nA; cB = nB; ++ui;
        if constexpr (ALIGN_EPI) { if (wr == 1) PG8_BAR; }
    }
    PG8_WAIT_V(0);
    if constexpr (!ALIGN_EPI) { if (wr == 0) PG8_BAR; }
    PG8_BAR;
    if constexpr (Epi::AFTER_DRAIN) { E.fused(acc, cur, wr, wc, fr, fq, lds, wid, lane); S.done(cur); }
#undef PG8_SA
#undef PG8_SB
#undef PG8_STAGE
#undef PG8_LDA
#undef PG8_LDB
#undef PG8_MMA
#undef PG8_WAIT_V
#undef PG8_WAIT_L
#undef PG8_BAR
#undef PG8_SCHED
}
}

constexpr int BATCH = 2, SEQ = 8192, DM = 1024, MTOK = BATCH * SEQ, CTXL = 256, MCTX = BATCH * CTXL, MALL = MTOK + MCTX;
constexpr int NHEAD = 8, NKVH = 2, HDIM = 64, ATTW = 512, KVW = 128, CONVW = 512, INW = 2304;
constexpr int NEXP = 16, CAP = 1024, DEXP = 1024;
constexpr int KVROWS = CTXL + SEQ;
constexpr float EPS_RMS = 1e-6f;
constexpr float QSCALE = 0.125f * 1.4426950408889634f;

namespace pg8 {
typedef unsigned u32x2 __attribute__((ext_vector_type(2)));
__device__ __forceinline__ float bf2f(unsigned short h) { return __uint_as_float((unsigned)h << 16); }

struct InProjOrder {
    int G, c;
    __device__ bool next(int i, Unit& u) const {
        const int L = i * G + c; constexpr int nM = 64, nN = 9, nwg = nM * nN;
        if (L >= nwg + 2) return false;
        if (L >= nwg) { u.pm = 64 + (L - nwg); u.pn = 2; return true; }
        int wgid = L; { const int q = nwg / NXCD, r = nwg % NXCD, xcd = wgid % NXCD, off = wgid / NXCD; wgid = (xcd < r ? xcd * (q + 1) : r * (q + 1) + (xcd - r) * q) + off; }
        const int nig = WGM * nN, gid = wgid / nig, fm = gid * WGM, gsz = (nM - fm) < WGM ? (nM - fm) : WGM;
        u.pm = fm + ((wgid % nig) % gsz); u.pn = (wgid % nig) / gsz; return true;
    }
    __device__ __forceinline__ void a_ready(const Unit&) const {}
    __device__ __forceinline__ void done(const Unit&) const {}
};
template <int NPE> struct MoeOrder {
    int G, c;
    __device__ bool next(int i, Unit& u) const {
        const int L = i * G + c; constexpr int U = NEXP * 8 * NPE;
        if (L >= U) return false;
        const int id = (L % NXCD) * (U / NXCD) + L / NXCD;
        const int e = id / (8 * NPE), sub = id % (8 * NPE);
        u.pm = e * 8 + (sub & 7); u.pn = e * NPE + (sub >> 3); return true;
    }
    __device__ __forceinline__ void a_ready(const Unit&) const {}
    __device__ __forceinline__ void done(const Unit&) const {}
};

struct EpiInProj {
    static constexpr bool PERM = true, AFTER_DRAIN = false;
    bf16_t *Q, *Kb, *Vt, *BG; const float* cosT; const float* sinT;
    __device__ __forceinline__ void operator()(const f32x4 (&acc)[2][2][4][2], const Unit& u, int wr, int wc, int fr, int fq) const {
        const int row0 = u.pm * BM + wr * 64 + fr;
        if (u.pn >= 3) {
            bf16_t* base = BG + (size_t)((u.pn - 3) >> 1) * ((size_t)MTOK * CONVW);
            const int col0 = ((u.pn - 3) & 1) * 256 + wc * 32 + 8 * fq;
#pragma unroll
            for (int ai = 0; ai < 2; ++ai)
#pragma unroll
                for (int m = 0; m < 4; ++m) { bf16_t* rowp = base + (size_t)(row0 + ai * HALF + m * 16) * CONVW + col0;
#pragma unroll
                    for (int bj = 0; bj < 2; ++bj) { const f32x4 v0 = acc[ai][bj][m][0], v1 = acc[ai][bj][m][1];
                        u32x4 w; w.x = cvt_pk_bf16(v0[0], v0[1]); w.y = cvt_pk_bf16(v0[2], v0[3]); w.z = cvt_pk_bf16(v1[0], v1[1]); w.w = cvt_pk_bf16(v1[2], v1[3]);
                        *(u32x4*)(rowp + bj * HALF) = w; } }
        } else if (u.pn < 2) {
            const int dbase = 16 * (wc & 1) + 4 * fq;
#pragma unroll
            for (int ai = 0; ai < 2; ++ai)
#pragma unroll
                for (int m = 0; m < 4; ++m) { const int r = row0 + ai * HALF + m * 16, t = r & (SEQ - 1), pos = (wc & 1) ? (t & 63) : (t >> 6);
                    const f32x4 cs = *(const f32x4*)(cosT + pos * 16 + 4 * fq), sn = *(const f32x4*)(sinT + pos * 16 + 4 * fq);
#pragma unroll
                    for (int bj = 0; bj < 2; ++bj) { const f32x4 x1 = acc[ai][bj][m][0], x2 = acc[ai][bj][m][1];
                        const f32x4 o1 = (x1 * cs - x2 * sn) * QSCALE, o2 = (x1 * sn + x2 * cs) * QSCALE;
                        bf16_t* p = Q + (size_t)r * ATTW + (u.pn * 4 + bj * 2 + (wc >> 1)) * HDIM + dbase;
                        u32x2 a, b; a.x = cvt_pk_bf16(o1[0], o1[1]); a.y = cvt_pk_bf16(o1[2], o1[3]); b.x = cvt_pk_bf16(o2[0], o2[1]); b.y = cvt_pk_bf16(o2[2], o2[3]);
                        *(u32x2*)p = a; *(u32x2*)(p + 32) = b; }
                    asm volatile("" ::: "memory"); }
        } else {
            const bool is_ctx = u.pm >= MTOK / BM; const int dbase = 16 * (wc & 1) + 4 * fq, kvh = wc >> 1;
#pragma unroll
            for (int ai = 0; ai < 2; ++ai)
#pragma unroll
                for (int m = 0; m < 4; ++m) { const int r = row0 + ai * HALF + m * 16; int b, kvrow; f32x4 o1 = acc[ai][0][m][0], o2 = acc[ai][0][m][1];
                    if (!is_ctx) { b = r >> 13; const int t = r & (SEQ - 1), pos = (wc & 1) ? (t & 63) : (t >> 6); kvrow = CTXL + t;
                        const f32x4 cs = *(const f32x4*)(cosT + pos * 16 + 4 * fq), sn = *(const f32x4*)(sinT + pos * 16 + 4 * fq);
                        const f32x4 x1 = o1, x2 = o2; o1 = x1 * cs - x2 * sn; o2 = x1 * sn + x2 * cs; }
                    else { const int rr = r - MTOK; b = rr >> 8; kvrow = rr & (CTXL - 1); }
                    bf16_t* p = Kb + ((size_t)(b * NKVH + kvh) * KVROWS + kvrow) * HDIM + dbase;
                    u32x2 a, c2; a.x = cvt_pk_bf16(o1[0], o1[1]); a.y = cvt_pk_bf16(o1[2], o1[3]); c2.x = cvt_pk_bf16(o2[0], o2[1]); c2.y = cvt_pk_bf16(o2[2], o2[3]);
                    *(u32x2*)p = a; *(u32x2*)(p + 32) = c2;
                    bf16_t* vp = Vt + ((size_t)(b * NKVH + kvh) * HDIM + 32 * (wc & 1) + 8 * fq) * KVROWS + kvrow;
#pragma unroll
                    for (int n = 0; n < 2; ++n) { const f32x4 v = acc[ai][1][m][n]; const unsigned w0 = cvt_pk_bf16(v[0], v[1]), w1 = cvt_pk_bf16(v[2], v[3]);
                        vp[(size_t)(4 * n + 0) * KVROWS] = (bf16_t)(w0 & 0xffffu); vp[(size_t)(4 * n + 1) * KVROWS] = (bf16_t)(w0 >> 16);
                        vp[(size_t)(4 * n + 2) * KVROWS] = (bf16_t)(w1 & 0xffffu); vp[(size_t)(4 * n + 3) * KVROWS] = (bf16_t)(w1 >> 16); }
                    asm volatile("" ::: "memory"); }
        }
    }
};
struct EpiOutProj {
    static constexpr bool PERM = false, AFTER_DRAIN = false;
    const float* x; float* x1; const float* modf;
    __device__ __forceinline__ void operator()(const f32x4 (&acc)[2][2][4][2], const Unit& u, int wr, int wc, int fr, int fq) const {
        const int row0 = u.pm * BM + wr * 64 + fr, col0 = u.pn * BM + wc * 32 + 4 * fq, b = (u.pm * BM) >> 13;
        f32x4 gt[2][2];
#pragma unroll
        for (int bj = 0; bj < 2; ++bj)
#pragma unroll
            for (int n = 0; n < 2; ++n) gt[bj][n] = *(const f32x4*)(modf + (size_t)b * 6 * DM + 2 * DM + col0 + bj * HALF + n * 16);
#pragma unroll
        for (int ai = 0; ai < 2; ++ai)
#pragma unroll
            for (int m = 0; m < 4; ++m) { const size_t off = (size_t)(row0 + ai * HALF + m * 16) * DM + col0;
#pragma unroll
                for (int bj = 0; bj < 2; ++bj)
#pragma unroll
                    for (int n = 0; n < 2; ++n) { const f32x4 xv = *(const f32x4*)(x + off + bj * HALF + n * 16); *(f32x4*)(x1 + off + bj * HALF + n * 16) = xv + gt[bj][n] * acc[ai][bj][m][n]; } }
    }
};
struct EpiGateUp {
    static constexpr bool PERM = true, AFTER_DRAIN = false;
    bf16_t* act;
    __device__ __forceinline__ void operator()(const f32x4 (&acc)[2][2][4][2], const Unit& u, int wr, int wc, int fr, int fq) const {
        const int row0 = u.pm * BM + wr * 64 + fr, col0 = (u.pn & 7) * HALF + wc * 32 + 8 * fq;
#pragma unroll
        for (int ai = 0; ai < 2; ++ai)
#pragma unroll
            for (int m = 0; m < 4; ++m) { float o[8];
#pragma unroll
                for (int n = 0; n < 2; ++n)
#pragma unroll
                    for (int i = 0; i < 4; ++i) { const float g = acc[ai][0][m][n][i], up = acc[ai][1][m][n][i];
                        o[4 * n + i] = g * up * __builtin_amdgcn_rcpf(1.0f + __builtin_amdgcn_exp2f(-1.4426950408889634f * g)); }
                u32x4 w; w.x = cvt_pk_bf16(o[0], o[1]); w.y = cvt_pk_bf16(o[2], o[3]); w.z = cvt_pk_bf16(o[4], o[5]); w.w = cvt_pk_bf16(o[6], o[7]);
                *(u32x4*)(act + (size_t)(row0 + ai * HALF + m * 16) * DEXP + col0) = w; }
    }
};
struct EpiDown {
    static constexpr bool PERM = true, AFTER_DRAIN = false;
    bf16_t* y; const float* gsel;
    __device__ __forceinline__ void operator()(const f32x4 (&acc)[2][2][4][2], const Unit& u, int wr, int wc, int fr, int fq) const {
        const int row0 = u.pm * BM + wr * 64 + fr, col0 = (u.pn & 3) * BM + wc * 32 + 8 * fq;
#pragma unroll
        for (int ai = 0; ai < 2; ++ai)
#pragma unroll
            for (int m = 0; m < 4; ++m) { const int r = row0 + ai * HALF + m * 16; const float g = gsel[r];
#pragma unroll
                for (int bj = 0; bj < 2; ++bj) { const f32x4 v0 = acc[ai][bj][m][0] * g, v1 = acc[ai][bj][m][1] * g;
                    u32x4 w; w.x = cvt_pk_bf16(v0[0], v0[1]); w.y = cvt_pk_bf16(v0[2], v0[3]); w.z = cvt_pk_bf16(v1[0], v1[1]); w.w = cvt_pk_bf16(v1[2], v1[3]);
                    *(u32x4*)(y + (size_t)r * DM + col0 + bj * HALF) = w; } }
    }
};
}
#ifndef PG8_SP2
#define PG8_SP2 true
#endif
#ifndef PG8_ALIGN
#define PG8_ALIGN true
#endif

constexpr int NWAVES = 8;
constexpr int NPH = 10;
#ifndef MK_N_LAUNCHES
#define MK_N_LAUNCHES 1
#endif
constexpr int N_LAUNCHES = MK_N_LAUNCHES;
static_assert(N_LAUNCHES == 1 || N_LAUNCHES == NPH, "MK_N_LAUNCHES is 1 or 10");

constexpr size_t MiB = 1u << 20;
constexpr size_t WS_CTL = 0, CTL_ZERO_BYTES = 64 * 1024;
constexpr size_t WS_MODP = 1 * MiB;
constexpr size_t WS_MODF = 2 * MiB + 512 * 1024;
constexpr size_t WS_ROPE = 2 * MiB + 768 * 1024;
constexpr size_t WS_AFF = 3 * MiB;
constexpr size_t WS_GSEL = 4 * MiB;
constexpr size_t WS_SEL = 5 * MiB;
constexpr size_t WS_WIN = 6 * MiB, WS_WO = 11 * MiB;
constexpr size_t WS_WGU = 16 * MiB, WS_WD = 80 * MiB;
constexpr size_t WS_XN = 112 * MiB;
constexpr size_t WS_MIX = 112 * MiB;
constexpr size_t WS_H2 = 146 * MiB;
constexpr size_t WS_ACT = 112 * MiB;
constexpr size_t WS_Q = 178 * MiB, WS_K = 194 * MiB, WS_VT = 198 * MiB + 512 * 1024, WS_BG = 203 * MiB, WS_CG = 219 * MiB, WS_HV = 235 * MiB;
constexpr size_t WS_XS = 178 * MiB;
constexpr size_t WS_Y = 178 * MiB;
constexpr size_t WS_END = 251 * MiB;
static_assert(WS_K + (size_t)BATCH * NKVH * KVROWS * HDIM * 2 <= WS_VT && WS_VT + (size_t)BATCH * NKVH * KVROWS * HDIM * 2 <= WS_BG, "K / V^T buffers");
static_assert(WS_XN + (size_t)MALL * DM * 2 <= WS_H2 && WS_H2 + (size_t)MTOK * DM * 2 <= WS_Q && WS_XS + (size_t)NEXP * 2 * CAP * DM * 2 <= WS_END, "d_ws map");
constexpr int CW_BAR = 1024;
constexpr int RING_OFF = 0, RING_BYTES = 131072;
constexpr int LDSCTL_OFF = RING_BYTES, MISC_OFF = LDSCTL_OFF + 320;
constexpr int LDS_BYTES = 147456;

#define GAS __attribute__((address_space(1)))
#define LAS __attribute__((address_space(3)))
typedef unsigned short bf16;
typedef unsigned v4u __attribute__((ext_vector_type(4)));
typedef unsigned v2u __attribute__((ext_vector_type(2)));
typedef float f32x4 __attribute__((ext_vector_type(4)));
typedef float f32x16 __attribute__((ext_vector_type(16)));
typedef short bf16x8 __attribute__((ext_vector_type(8)));
typedef GAS unsigned gu32;
#define RLX_AGENT __ATOMIC_RELAXED, __HIP_MEMORY_SCOPE_AGENT
#define LDS_WAIT() asm volatile("s_waitcnt lgkmcnt(0)" ::: "memory")
#define VM_WAIT() asm volatile("s_waitcnt vmcnt(0)" ::: "memory")
__device__ __forceinline__ unsigned f2bf(float f) { unsigned u = __builtin_bit_cast(unsigned, f); return (u + 0x7fffu + ((u >> 16) & 1u)) >> 16; }
__device__ __forceinline__ unsigned pk2(float lo, float hi) { return f2bf(lo) | (f2bf(hi) << 16); }
__device__ __forceinline__ float bflo(unsigned w) { return __uint_as_float(w << 16); }
__device__ __forceinline__ float bfhi(unsigned w) { return __uint_as_float(w & 0xffff0000u); }
#define XB_TMO      128
#define XB_XCNT(j)  (256  + 64 * (j))
#define XB_XSUB(j)  (1280 + 64 * (j))
#define XB_XGEN(j)  (2304 + 64 * (j))
#define XB_TOP      3328
#define XB_TOPGEN   3392
#define XCD_BAR_WORDS 3456
#define XB_SPIN_CAP (1u << 18)

__device__ __forceinline__ unsigned xb_ld(unsigned* p)              { return __hip_atomic_load(p, __ATOMIC_RELAXED, __HIP_MEMORY_SCOPE_AGENT); }
__device__ __forceinline__ unsigned xb_add(unsigned* p, unsigned v) { return __hip_atomic_fetch_add(p, v, __ATOMIC_RELAXED, __HIP_MEMORY_SCOPE_AGENT); }
__device__ __forceinline__ unsigned xb_xcc_id() { return (unsigned)__builtin_amdgcn_s_getreg((3 << 11) | 20) & 0xFu; }
#define XB_SPIN(cond, bar) do { unsigned _sp = 0; while (cond) { __builtin_amdgcn_s_sleep(1); \
    if ((++_sp & 255u) == 0u) { if (xb_ld(&(bar)[XB_TMO])) break; if (_sp > XB_SPIN_CAP) { atomicAdd(&(bar)[XB_TMO], 1u); break; } } } } while (0)

struct XcdBarrier {
    unsigned* bar; unsigned x;
    volatile LAS unsigned* st;
    int w;
};

__device__ __forceinline__ int xb_lane() { int l; asm volatile("v_mbcnt_lo_u32_b32 %0, -1, 0\n\tv_mbcnt_hi_u32_b32 %0, -1, %0" : "=v"(l)); return l; }
#define MY_TID0() (b.w == 0 && xb_lane() == 0)
__device__ __forceinline__ XcdBarrier xcd_barrier_post(unsigned* bar, volatile LAS unsigned* st, int w) {
    XcdBarrier b; b.bar = bar; b.x = xb_xcc_id(); b.st = st; b.w = w;
    if (MY_TID0()) (void)xb_add(&bar[XB_XCNT(b.x)], 1u);
    return b;
}
__device__ __forceinline__ void xcd_barrier_complete(unsigned* bar, unsigned x, unsigned& nloc, unsigned& nx) {
    const unsigned G = gridDim.x * gridDim.y * gridDim.z;
    unsigned sum, cnt, mine, sp = 0u;
    for (;;) {
        sum = 0u; cnt = 0u; mine = 0u;
#pragma unroll
        for (unsigned j = 0; j < 16; ++j) { const unsigned c = xb_ld(&bar[XB_XCNT(j)]); sum += c; cnt += (c > 0u) ? 1u : 0u; mine = (j == x) ? c : mine; }
        if (sum == G) break;
        __builtin_amdgcn_s_sleep(1);
        if ((++sp & 255u) == 0u) { if (xb_ld(&bar[XB_TMO])) break; if (sp > XB_SPIN_CAP) { atomicAdd(&bar[XB_TMO], 1u); break; } }
    }
    nloc = mine > 0u ? mine : 1u; nx = cnt > 0u ? cnt : 1u;
}

__device__ __forceinline__ void xcd_barrier(const XcdBarrier& b) {
    asm volatile("s_waitcnt vmcnt(0)" ::: "memory");
    __syncthreads();
    if (MY_TID0()) {
        unsigned* bar = b.bar;
        __builtin_amdgcn_s_waitcnt(0);
        unsigned nloc = b.st[0], nx = b.st[1];
        if (nloc == 0u) { xcd_barrier_complete(bar, b.x, nloc, nx); b.st[0] = nloc; b.st[1] = nx; }
        const unsigned old = xb_add(&bar[XB_XSUB(b.x)], 1u);
        const unsigned gen = old / nloc;
        if (old + 1u == (gen + 1u) * nloc) {
            __builtin_amdgcn_fence(__ATOMIC_RELEASE, "agent");
            asm volatile("s_waitcnt vmcnt(0)" ::: "memory");
            const unsigned og = xb_add(&bar[XB_TOP], 1u);
            const unsigned tg = og / nx;
            if (og + 1u == (tg + 1u) * nx) xb_add(&bar[XB_TOPGEN], 1u);
            else XB_SPIN(xb_ld(&bar[XB_TOPGEN]) == tg, bar);
            __builtin_amdgcn_fence(__ATOMIC_ACQUIRE, "agent");
            xb_add(&bar[XB_XGEN(b.x)], 1u);
            asm volatile("s_waitcnt vmcnt(0)" ::: "memory");
        } else {
            XB_SPIN(xb_ld(&bar[XB_XGEN(b.x)]) == gen, bar);
            __builtin_amdgcn_fence(__ATOMIC_ACQUIRE, "agent");
            asm volatile("s_waitcnt vmcnt(0)" ::: "memory");
        }
    }
    __syncthreads();
}

__device__ __forceinline__ int lane_id() { int l; asm volatile("v_mbcnt_lo_u32_b32 %0, -1, 0\n\tv_mbcnt_hi_u32_b32 %0, -1, %0" : "=v"(l)); return l; }
struct Frame {
    LAS unsigned char* lds;
    volatile LAS unsigned* MISC;
    gu32* ctl;
    int wave, vcu, G;
    const float *x, *c, *ctx, *c_ctx, *w_ada, *b_ada, *g_mix, *w_in, *conv_w, *sink, *w_out, *g_ffn, *w_router, *w_gate, *w_up, *w_down, *g_final;
    float* out; unsigned char* ws;
};
__device__ __forceinline__ int ftid(const Frame& F) { return F.wave * 64 + lane_id(); }
__device__ __forceinline__ float wave_sum(float v) {
#pragma unroll
    for (int o = 1; o < 64; o <<= 1) v += __shfl_xor(v, o);
    return v;
}
typedef float f32x2_t __attribute__((ext_vector_type(2))); typedef __bf16 bf16x2_t __attribute__((ext_vector_type(2)));
__device__ __forceinline__ unsigned cvtpk(float lo, float hi) { f32x2_t v = {lo, hi}; bf16x2_t b = __builtin_convertvector(v, bf16x2_t); return __builtin_bit_cast(unsigned, b); }

template <int MODE> __device__ __forceinline__ int wt_row(int n, int row_off) {
    if (MODE == 0) return row_off + n;
    if (MODE == 1) { if (n >= ATTW + KVW) return n; const int d = n & 63; return (n & ~63) + 8 * ((d & 31) >> 2) + 4 * (d >> 5) + (d & 3); }
    return row_off + (n >> 7) * 256 + (n & 127) + (MODE == 3 ? 128 : 0);
}
template <int MODE> __device__ __forceinline__ void p0_transpose_item(const float* W, int K, int N, bf16* WT, int row_off, LAS float* scr, int item, int lane) {
    const int nblk = N / 32, kb = item / nblk, nb = item % nblk, k0 = 64 * kb, n0 = 32 * nb;
#pragma unroll 8
    for (int i = 0; i < 32; ++i) { const int kk = 2 * i + (lane >> 5); scr[kk * 33 + (lane & 31)] = W[(size_t)(k0 + kk) * N + n0 + (lane & 31)]; }
    LDS_WAIT(); asm volatile("" ::: "memory");
    const int c = lane & 7;
#pragma unroll
    for (int j = 0; j < 4; ++j) { const int n = (lane >> 3) + 8 * j; const LAS float* s = scr + (8 * c) * 33 + n;
        v4u o; o.x = pk2(s[0 * 33], s[1 * 33]); o.y = pk2(s[2 * 33], s[3 * 33]); o.z = pk2(s[4 * 33], s[5 * 33]); o.w = pk2(s[6 * 33], s[7 * 33]);
        *(GAS v4u*)(WT + (size_t)wt_row<MODE>(n0 + n, row_off) * K + k0 + 8 * c) = o; }
    LDS_WAIT(); asm volatile("" ::: "memory");
}
__device__ __forceinline__ void p0_prologue(Frame& F) {
    const int lane = lane_id(), tid = F.wave * 64 + lane;
    LAS float* sil = (LAS float*)(F.lds + LDSCTL_OFF + 1024);
    float* MODP = (float*)(F.ws + WS_MODP);
    for (int task = F.vcu; task < 192; task += F.G) {
        const int kc = task / 12, jb = task % 12;
        __syncthreads();
        if (tid < 192) { const int v = tid >> 6, k = kc * 64 + (tid & 63); const float cv = (v < 2) ? F.c[v * DM + k] : F.c_ctx[k]; sil[tid] = cv / (1.0f + __expf(-cv)); }
        __syncthreads();
        const int j = jb * 512 + tid; const float* wp = F.w_ada + (size_t)(kc * 64) * (6 * DM) + j; float a0 = 0.f, a1 = 0.f, a2 = 0.f;
#pragma unroll 16
        for (int kk = 0; kk < 64; ++kk) { const float w = wp[(size_t)kk * (6 * DM)]; a0 += sil[kk] * w; a1 += sil[64 + kk] * w; a2 += sil[128 + kk] * w; }
        MODP[(size_t)(kc * 3 + 0) * (6 * DM) + j] = a0; MODP[(size_t)(kc * 3 + 1) * (6 * DM) + j] = a1; MODP[(size_t)(kc * 3 + 2) * (6 * DM) + j] = a2;
    }
    if (F.vcu == (192 % F.G)) {
        float* cosT = (float*)(F.ws + WS_ROPE); float* sinT = cosT + 128 * 16;
        for (int i = tid; i < 2048; i += NWAVES * 64) { const int pos = i >> 4, f = i & 15;
            const double b4 = (f & 3) == 0 ? 1.0 : ((f & 3) == 1 ? 0.5623413251903491 : ((f & 3) == 2 ? 0.31622776601683794 : 0.1778279410038923));
            const double p10 = (f >> 2) == 0 ? 1.0 : ((f >> 2) == 1 ? 0.1 : ((f >> 2) == 2 ? 0.01 : 0.001));
            const double ang = (double)pos * (b4 * p10); const double kq = __builtin_rint(ang * 0.6366197723675814);
            const double r = (ang - kq * 1.5707963267948966) - kq * 6.123233995736766e-17; const int q = ((int)kq) & 3; const double r2 = r * r;
            const double s = r * (1.0 + r2 * (-1.0 / 6 + r2 * (1.0 / 120 + r2 * (-1.0 / 5040 + r2 * (1.0 / 362880 + r2 * (-1.0 / 39916800 + r2 * (1.0 / 6227020800.0)))))));
            const double c = 1.0 + r2 * (-0.5 + r2 * (1.0 / 24 + r2 * (-1.0 / 720 + r2 * (1.0 / 40320 + r2 * (-1.0 / 3628800 + r2 * (1.0 / 479001600.0 + r2 * (-1.0 / 87178291200.0)))))));
            const double cc = q == 0 ? c : (q == 1 ? -s : (q == 2 ? -c : s)), ss = q == 0 ? s : (q == 1 ? c : (q == 2 ? -s : -c));
            cosT[i] = (float)cc; sinT[i] = (float)ss; }
    }
    __syncthreads();
    LAS float* scr = (LAS float*)(F.lds + RING_OFF + F.wave * 16384);
    const int gw = F.vcu * NWAVES + F.wave, NGW = F.G * NWAVES;
    constexpr int I_IN = (DM / 64) * (INW / 32), I_O = (DM / 64) * (DM / 32), I_E = (DM / 64) * (DEXP / 32);
    constexpr int NITEMS = I_IN + I_O + 3 * NEXP * I_E;
    bf16* WIN = (bf16*)(F.ws + WS_WIN); bf16* WO = (bf16*)(F.ws + WS_WO); bf16* WGU = (bf16*)(F.ws + WS_WGU); bf16* WD = (bf16*)(F.ws + WS_WD);
    for (int it = gw; it < NITEMS; it += NGW) {
        int r = it;
        if (r < I_IN) { p0_transpose_item<1>(F.w_in, DM, INW, WIN, 0, scr, r, lane); continue; } r -= I_IN;
        if (r < I_O) { p0_transpose_item<0>(F.w_out, DM, DM, WO, 0, scr, r, lane); continue; } r -= I_O;
        const int mat = r / (NEXP * I_E), rr = r % (NEXP * I_E), e = rr / I_E, ie = rr % I_E;
        if (mat == 0) p0_transpose_item<2>(F.w_gate + (size_t)e * DM * DEXP, DM, DEXP, WGU, e * 2 * DEXP, scr, ie, lane);
        else if (mat == 1) p0_transpose_item<3>(F.w_up + (size_t)e * DM * DEXP, DM, DEXP, WGU, e * 2 * DEXP, scr, ie, lane);
        else p0_transpose_item<0>(F.w_down + (size_t)e * DEXP * DM, DEXP, DM, WD, e * DM, scr, ie, lane);
    }
}

__device__ __forceinline__ float mod_sum(const float* MODP, const float* b_ada, int v, int col) {
    float s = b_ada[col];
#pragma unroll
    for (int kc = 0; kc < 16; ++kc) s += MODP[(size_t)(kc * 3 + v) * (6 * DM) + col];
    return s;
}
__device__ __forceinline__ void p1_norm(Frame& F) {
    const int lane = lane_id(), tid = F.wave * 64 + lane;
    const float* MODP = (const float*)(F.ws + WS_MODP); float* MODF = (float*)(F.ws + WS_MODF);
    LAS float* tA = (LAS float*)(F.lds); LAS float* tB = tA + 3 * DM;
    for (int idx = tid; idx < 3 * 2 * DM; idx += NWAVES * 64) { const int v = idx / (2 * DM), q = idx % (2 * DM); const float s = mod_sum(MODP, F.b_ada, v, q);
        if (q < DM) tB[v * DM + q] = s; else tA[v * DM + q - DM] = F.g_mix[q - DM] * (1.0f + s); }
    for (int o = F.vcu * (NWAVES * 64) + tid; o < 3 * 6 * DM; o += F.G * NWAVES * 64) MODF[o] = mod_sum(MODP, F.b_ada, o / (6 * DM), o % (6 * DM));
    __syncthreads();
    bf16* XN = (bf16*)(F.ws + WS_XN);
    const int gw = F.vcu * NWAVES + F.wave, NGW = F.G * NWAVES;
    for (int m = gw; m < MALL; m += NGW) {
        const int v = m < SEQ ? 0 : (m < MTOK ? 1 : 2);
        const float* src = m < MTOK ? F.x + (size_t)m * DM : F.ctx + (size_t)(m - MTOK) * DM;
        const GAS f32x4* xr = (const GAS f32x4*)src + lane;
        f32x4 xv[4]; float ss = 0.f;
#pragma unroll
        for (int j = 0; j < 4; ++j) { xv[j] = xr[64 * j]; ss += (xv[j].x * xv[j].x + xv[j].y * xv[j].y) + (xv[j].z * xv[j].z + xv[j].w * xv[j].w); }
        const float rstd = 1.0f / sqrtf(wave_sum(ss) * (1.0f / DM) + EPS_RMS);
        GAS unsigned long long* o8 = (GAS unsigned long long*)(XN + (size_t)m * DM) + lane;
#pragma unroll
        for (int j = 0; j < 4; ++j) { const f32x4 a = *(const LAS f32x4*)(tA + v * DM + 4 * lane + 256 * j), sh = *(const LAS f32x4*)(tB + v * DM + 4 * lane + 256 * j);
            const f32x4 h = xv[j] * rstd * a + sh;
            o8[64 * j] = (unsigned long long)cvtpk(h.x, h.y) | ((unsigned long long)cvtpk(h.z, h.w) << 32); }
    }
}

#define MFMA32(a, b, c) __builtin_amdgcn_mfma_f32_32x32x16_bf16((a), (b), (c), 0, 0, 0)
__device__ __forceinline__ int crow(int r, int hi) { return (r & 3) + 8 * (r >> 2) + 4 * hi; }
__device__ __forceinline__ bf16x8 pack8(const f32x16& p, int s) {
    v4u w; w.x = cvtpk(p[8 * s + 0], p[8 * s + 1]); w.y = cvtpk(p[8 * s + 2], p[8 * s + 3]); w.z = cvtpk(p[8 * s + 4], p[8 * s + 5]); w.w = cvtpk(p[8 * s + 6], p[8 * s + 7]);
    return __builtin_bit_cast(bf16x8, w);
}
__device__ __forceinline__ void attn_unit(Frame& F, int u) {
    const int b = u >> 7, kvh = (u >> 6) & 1, n = u & 63;
    const int lane = lane_id(), r32 = lane & 31, hh = lane >> 5, g = F.wave >> 1, half = F.wave & 1, h = kvh * 4 + g;
    const bf16* Q = (const bf16*)(F.ws + WS_Q); bf16* MIX = (bf16*)(F.ws + WS_MIX);
    const bf16* Kbase = (const bf16*)(F.ws + WS_K) + (size_t)(b * NKVH + kvh) * KVROWS * HDIM;
    const bf16* Vbase = (const bf16*)(F.ws + WS_VT) + (size_t)(b * NKVH + kvh) * HDIM * KVROWS;
    const float sk2 = F.sink[h] * 1.4426950408889634f;
    const int q0 = n * 128 + half * 64;
    bf16x8 qf[2][4];
#pragma unroll
    for (int sb = 0; sb < 2; ++sb)
#pragma unroll
        for (int s = 0; s < 4; ++s) qf[sb][s] = *(const bf16x8*)(Q + (size_t)(b * SEQ + q0 + sb * 32 + r32) * ATTW + h * HDIM + 16 * s + 8 * hh);
    f32x16 o[2][2]; float mrun[2], lrun[2];
#pragma unroll
    for (int sb = 0; sb < 2; ++sb) { mrun[sb] = sk2; lrun[sb] = hh == 0 ? 1.0f : 0.0f;
#pragma unroll
        for (int db = 0; db < 2; ++db)
#pragma unroll
            for (int i = 0; i < 16; ++i) o[sb][db][i] = 0.f; }
    for (int tile = 0; tile < 10; ++tile) {
        int krow0, kpos0 = 0; const bool local = tile >= 4;
        if (!local) krow0 = tile * 64;
        else { kpos0 = n * 128 - 128 + (tile - 4) * 64; if (kpos0 < 0 || kpos0 >= SEQ) continue; krow0 = CTXL + kpos0; }
        bf16x8 kf[2][4], vf[2][4];
#pragma unroll
        for (int kb = 0; kb < 2; ++kb)
#pragma unroll
            for (int s = 0; s < 4; ++s) kf[kb][s] = *(const bf16x8*)(Kbase + (size_t)(krow0 + kb * 32 + r32) * HDIM + 16 * s + 8 * hh);
#pragma unroll
        for (int db = 0; db < 2; ++db)
#pragma unroll
            for (int ks = 0; ks < 4; ++ks) { const bf16* vp = Vbase + (size_t)(db * 32 + r32) * KVROWS + krow0 + 16 * ks + 4 * hh;
                const v2u lo = *(const v2u*)vp, hi = *(const v2u*)(vp + 8); v4u w; w.x = lo.x; w.y = lo.y; w.z = hi.x; w.w = hi.y; vf[db][ks] = __builtin_bit_cast(bf16x8, w); }
        const bool needmask = local && (tile < 6 || tile >= 8);
#pragma unroll
        for (int sb = 0; sb < 2; ++sb) {
            f32x16 p0, p1;
#pragma unroll
            for (int i = 0; i < 16; ++i) { p0[i] = 0.f; p1[i] = 0.f; }
#pragma unroll
            for (int s = 0; s < 4; ++s) { p0 = MFMA32(kf[0][s], qf[sb][s], p0); p1 = MFMA32(kf[1][s], qf[sb][s], p1); }
            if (needmask) { const int qpos = q0 + sb * 32 + r32;
#pragma unroll
                for (int i = 0; i < 16; ++i) { const int dk = kpos0 + crow(i, hh) - qpos; if (dk > 128 || dk < -128) p0[i] = -1e30f; if (dk + 32 > 128 || dk + 32 < -128) p1[i] = -1e30f; } }
            float mx = fmaxf(p0[0], p1[0]);
#pragma unroll
            for (int i = 1; i < 16; ++i) mx = fmaxf(mx, fmaxf(p0[i], p1[i]));
            mx = fmaxf(mx, __shfl_xor(mx, 32));
            const float mnew = fmaxf(mrun[sb], mx), alpha = __builtin_amdgcn_exp2f(mrun[sb] - mnew); mrun[sb] = mnew;
            float ps = 0.f;
#pragma unroll
            for (int i = 0; i < 16; ++i) { p0[i] = __builtin_amdgcn_exp2f(p0[i] - mnew); p1[i] = __builtin_amdgcn_exp2f(p1[i] - mnew); ps += p0[i] + p1[i]; }
            lrun[sb] = lrun[sb] * alpha + ps;
#pragma unroll
            for (int db = 0; db < 2; ++db)
#pragma unroll
                for (int i = 0; i < 16; ++i) o[sb][db][i] *= alpha;
            bf16x8 pb[4]; pb[0] = pack8(p0, 0); pb[1] = pack8(p0, 1); pb[2] = pack8(p1, 0); pb[3] = pack8(p1, 1);
#pragma unroll
            for (int db = 0; db < 2; ++db)
#pragma unroll
                for (int ks = 0; ks < 4; ++ks) o[sb][db] = MFMA32(vf[db][ks], pb[ks], o[sb][db]);
        }
    }
#pragma unroll
    for (int sb = 0; sb < 2; ++sb) { const float lt = lrun[sb] + __shfl_xor(lrun[sb], 32), inv = 1.0f / lt;
        bf16* dst = MIX + (size_t)(b * SEQ + q0 + sb * 32 + r32) * DM + h * HDIM;
#pragma unroll
        for (int db = 0; db < 2; ++db)
#pragma unroll
            for (int g4 = 0; g4 < 4; ++g4) { v2u w; w.x = cvtpk(o[sb][db][4 * g4] * inv, o[sb][db][4 * g4 + 1] * inv); w.y = cvtpk(o[sb][db][4 * g4 + 2] * inv, o[sb][db][4 * g4 + 3] * inv);
                *(v2u*)(dst + db * 32 + 8 * g4 + 4 * hh) = w; } }
}
__device__ __forceinline__ void unpack8(const v4u w, float (&f)[8]) { f[0] = bflo(w.x); f[1] = bfhi(w.x); f[2] = bflo(w.y); f[3] = bfhi(w.y); f[4] = bflo(w.z); f[5] = bfhi(w.z); f[6] = bflo(w.w); f[7] = bfhi(w.w); }
__device__ __forceinline__ void p3_attn_conv(Frame& F) {
    const int tid = F.wave * 64 + lane_id();
    for (int u = F.vcu; u < BATCH * NKVH * (SEQ / 128); u += F.G) attn_unit(F, u);
    const bf16* BG = (const bf16*)(F.ws + WS_BG); const bf16* CG = (const bf16*)(F.ws + WS_CG); const bf16* HV = (const bf16*)(F.ws + WS_HV); bf16* MIX = (bf16*)(F.ws + WS_MIX);
    for (int idx = F.vcu * (NWAVES * 64) + tid; idx < MTOK * (CONVW / 8); idx += F.G * NWAVES * 64) {
        const int row = idx >> 6, c8 = (idx & 63) * 8, t = row & (SEQ - 1); const size_t off = (size_t)row * CONVW + c8;
        float bgv[8], uc[8], up[8], un[8], a[8], bq[8];
        unpack8(*(const v4u*)(BG + off), bgv);
        unpack8(*(const v4u*)(CG + off), a); unpack8(*(const v4u*)(HV + off), bq);
#pragma unroll
        for (int i = 0; i < 8; ++i) uc[i] = a[i] * bq[i];
        if (t > 0) { unpack8(*(const v4u*)(CG + off - CONVW), a); unpack8(*(const v4u*)(HV + off - CONVW), bq);
#pragma unroll
            for (int i = 0; i < 8; ++i) up[i] = a[i] * bq[i]; }
        else {
#pragma unroll
            for (int i = 0; i < 8; ++i) up[i] = 0.f; }
        if (t < SEQ - 1) { unpack8(*(const v4u*)(CG + off + CONVW), a); unpack8(*(const v4u*)(HV + off + CONVW), bq);
#pragma unroll
            for (int i = 0; i < 8; ++i) un[i] = a[i] * bq[i]; }
        else {
#pragma unroll
            for (int i = 0; i < 8; ++i) un[i] = 0.f; }
        float r[8];
#pragma unroll
        for (int i = 0; i < 8; ++i) r[i] = bgv[i] * (F.conv_w[c8 + i] * up[i] + F.conv_w[CONVW + c8 + i] * uc[i] + F.conv_w[2 * CONVW + c8 + i] * un[i]);
        v4u w; w.x = cvtpk(r[0], r[1]); w.y = cvtpk(r[2], r[3]); w.z = cvtpk(r[4], r[5]); w.w = cvtpk(r[6], r[7]);
        *(v4u*)(MIX + (size_t)row * DM + ATTW + c8) = w;
    }
}

__device__ __forceinline__ void p5_norm_router(Frame& F) {
    const int lane = lane_id(), tid = F.wave * 64 + lane;
    const float* MODF = (const float*)(F.ws + WS_MODF);
    LAS float* wr = (LAS float*)(F.lds);
    LAS float* tA = wr + NEXP * DM; LAS float* tB = tA + 2 * DM;
    for (int i = tid; i < NEXP * DM; i += NWAVES * 64) { const int k = i >> 4, e = i & 15; wr[e * DM + k] = F.w_router[i]; }
    for (int i = tid; i < 2 * DM; i += NWAVES * 64) { const int b = i >> 10, k = i & (DM - 1);
        tA[i] = F.g_ffn[k] * (1.0f + MODF[(size_t)b * 6 * DM + 4 * DM + k]); tB[i] = MODF[(size_t)b * 6 * DM + 3 * DM + k]; }
    __syncthreads();
    bf16* H2 = (bf16*)(F.ws + WS_H2); float* AFF = (float*)(F.ws + WS_AFF);
    const int gw = F.vcu * NWAVES + F.wave, NGW = F.G * NWAVES;
    for (int m = gw; m < MTOK; m += NGW) {
        const int b = m >> 13, t = m & (SEQ - 1);
        const GAS f32x4* xr = (const GAS f32x4*)(F.out + (size_t)m * DM) + lane;
        f32x4 hv[4]; float ss = 0.f;
#pragma unroll
        for (int j = 0; j < 4; ++j) { hv[j] = xr[64 * j]; ss += (hv[j].x * hv[j].x + hv[j].y * hv[j].y) + (hv[j].z * hv[j].z + hv[j].w * hv[j].w); }
        const float rstd = 1.0f / sqrtf(wave_sum(ss) * (1.0f / DM) + EPS_RMS);
        GAS unsigned long long* o8 = (GAS unsigned long long*)(H2 + (size_t)m * DM) + lane;
#pragma unroll
        for (int j = 0; j < 4; ++j) { const f32x4 a = *(const LAS f32x4*)(tA + b * DM + 4 * lane + 256 * j), sh = *(const LAS f32x4*)(tB + b * DM + 4 * lane + 256 * j);
            hv[j] = hv[j] * rstd * a + sh;
            o8[64 * j] = (unsigned long long)cvtpk(hv[j].x, hv[j].y) | ((unsigned long long)cvtpk(hv[j].z, hv[j].w) << 32); }
        float r8[8];
#pragma unroll
        for (int e = 0; e < 8; ++e) { float s0 = 0.f, s1 = 0.f;
#pragma unroll
            for (int j = 0; j < 4; ++j) { const f32x4 w0 = *(const LAS f32x4*)(wr + e * DM + 4 * lane + 256 * j), w1 = *(const LAS f32x4*)(wr + (e + 8) * DM + 4 * lane + 256 * j);
                s0 += (hv[j].x * w0.x + hv[j].y * w0.y) + (hv[j].z * w0.z + hv[j].w * w0.w); s1 += (hv[j].x * w1.x + hv[j].y * w1.y) + (hv[j].z * w1.z + hv[j].w * w1.w); }
            const bool up = (lane & 32) != 0; r8[e] = (up ? s1 : s0) + __shfl_xor(up ? s0 : s1, 32);
            asm volatile("" ::: "memory"); }
        float r4[4], r2[2];
#pragma unroll
        for (int e = 0; e < 4; ++e) { const bool up = (lane & 16) != 0; r4[e] = (up ? r8[e + 4] : r8[e]) + __shfl_xor(up ? r8[e] : r8[e + 4], 16); }
#pragma unroll
        for (int e = 0; e < 2; ++e) { const bool up = (lane & 8) != 0; r2[e] = (up ? r4[e + 2] : r4[e]) + __shfl_xor(up ? r4[e] : r4[e + 2], 8); }
        float lg; { const bool up = (lane & 4) != 0; lg = (up ? r2[1] : r2[0]) + __shfl_xor(up ? r2[0] : r2[1], 4); }
        lg += __shfl_xor(lg, 2); lg += __shfl_xor(lg, 1);
        float mx = lg;
#pragma unroll
        for (int o = 4; o < 64; o <<= 1) mx = fmaxf(mx, __shfl_xor(mx, o));
        const float ex = __expf(lg - mx); float den = ex;
#pragma unroll
        for (int o = 4; o < 64; o <<= 1) den += __shfl_xor(den, o);
        const float mine = ex / den; const int myexp = ((lane >> 5) & 1) * 8 + ((lane >> 4) & 1) * 4 + ((lane >> 3) & 1) * 2 + ((lane >> 2) & 1);
        if ((lane & 3) == 0) AFF[(size_t)(b * NEXP + myexp) * SEQ + t] = mine;
    }
}

__device__ __forceinline__ int block_excl_scan(int v, LAS int* wsum, int lane, int wave, int& total) {
    int x = v;
#pragma unroll
    for (int o = 1; o < 64; o <<= 1) { const int y = __shfl_up(x, o); if (lane >= o) x += y; }
    if (lane == 63) wsum[wave] = x;
    __syncthreads();
    int base = 0, tot = 0;
#pragma unroll
    for (int w = 0; w < NWAVES; ++w) { const int s = wsum[w]; base += (w < wave) ? s : 0; tot += s; }
    __syncthreads();
    total = tot; return base + x - v;
}
__device__ __forceinline__ void p6_topk_task(Frame& F, int task) {
    const int b = task >> 7, e = (task >> 3) & 15, part = task & 7, lane = lane_id(), tid = F.wave * 64 + lane;
    LAS unsigned* keys = (LAS unsigned*)(F.lds);
    LAS unsigned* hist = (LAS unsigned*)(F.lds + 32768);
    LAS int* misc = (LAS int*)(F.lds + 32768 + 1024);
    LAS int* list = (LAS int*)(F.lds + 36864);
    const float* aff = (const float*)(F.ws + WS_AFF) + (size_t)(b * NEXP + e) * SEQ;
    __syncthreads();
    for (int i = tid; i < SEQ / 4; i += NWAVES * 64) *(LAS v4u*)(keys + 4 * i) = *(const v4u*)(aff + 4 * i);
    __syncthreads();
    unsigned prefix = 0u, mask = 0u; int kk = CAP;
    for (int pass = 3; pass >= 0; --pass) {
        if (tid < 256) hist[tid] = 0u;
        __syncthreads();
        const int sh = pass * 8;
#pragma unroll 4
        for (int j = 0; j < 16; ++j) { const unsigned k = keys[tid + 512 * j]; if ((k & mask) == prefix) __hip_atomic_fetch_add(hist + ((k >> sh) & 255u), 1u, __ATOMIC_RELAXED, __HIP_MEMORY_SCOPE_WORKGROUP); }
        __syncthreads();
        if (F.wave == 0) {
            const int c0 = (int)hist[255 - 4 * lane], c1 = (int)hist[254 - 4 * lane], c2 = (int)hist[253 - 4 * lane], c3 = (int)hist[252 - 4 * lane];
            const int s = c0 + c1 + c2 + c3; int incl = s;
#pragma unroll
            for (int o = 1; o < 64; o <<= 1) { const int y = __shfl_up(incl, o); if (lane >= o) incl += y; }
            const int excl = incl - s;
            if (excl < kk && incl >= kk) { const int r = kk - excl; int bin, above;
                if (r <= c0) { bin = 255 - 4 * lane; above = 0; } else if (r <= c0 + c1) { bin = 254 - 4 * lane; above = c0; }
                else if (r <= c0 + c1 + c2) { bin = 253 - 4 * lane; above = c0 + c1; } else { bin = 252 - 4 * lane; above = c0 + c1 + c2; }
                misc[0] = bin; misc[1] = r - above; }
        }
        __syncthreads();
        prefix |= (unsigned)misc[0] << sh; mask |= 255u << sh; kk = misc[1];
        __syncthreads();
    }
    const unsigned thr = prefix; const int need = kk;
    const int t0 = part * (SEQ / 8);
    int cgt = 0, ceq = 0;
#pragma unroll 4
    for (int j = 0; j < 16; ++j) { const int i = tid + 512 * j; const unsigned k = keys[i]; if (i < t0) { cgt += (k > thr) ? 1 : 0; ceq += (k == thr) ? 1 : 0; } }
    int gt_before, eq_before;
    (void)block_excl_scan(cgt, misc + 16, lane, F.wave, gt_before);
    (void)block_excl_scan(ceq, misc + 16, lane, F.wave, eq_before);
    const int tA = t0 + 2 * tid; const unsigned kA = keys[tA], kB = keys[tA + 1];
    const int eqA = (kA == thr) ? 1 : 0, eqB = (kB == thr) ? 1 : 0; int dummy;
    const int eqx = block_excl_scan(eqA + eqB, misc + 16, lane, F.wave, dummy);
    const int eposA = eq_before + eqx, eposB = eposA + eqA;
    const int selA = (kA > thr || (eqA && eposA < need)) ? 1 : 0, selB = (kB > thr || (eqB && eposB < need)) ? 1 : 0;
    int nloc;
    const int sx = block_excl_scan(selA + selB, misc + 16, lane, F.wave, nloc);
    const int sel_before = gt_before + (eq_before < need ? eq_before : need);
    int* SEL = (int*)(F.ws + WS_SEL); float* GSEL = (float*)(F.ws + WS_GSEL);
    const int slotA = sel_before + sx, slotB = slotA + selA; const size_t eb = (size_t)(e * 2 + b) * CAP;
    SEL[(size_t)(b * SEQ + tA) * NEXP + e] = selA ? slotA : -1; SEL[(size_t)(b * SEQ + tA + 1) * NEXP + e] = selB ? slotB : -1;
    if (selA) { GSEL[eb + slotA] = __uint_as_float(kA); list[sx] = tA; }
    if (selB) { GSEL[eb + slotB] = __uint_as_float(kB); list[sx + selA] = tA + 1; }
    __syncthreads();
    const bf16* H2 = (const bf16*)(F.ws + WS_H2); bf16* XS = (bf16*)(F.ws + WS_XS);
    for (int r = F.wave; r < nloc; r += NWAVES) { const int tok = list[r];
        const v4u* src = (const v4u*)(H2 + (size_t)(b * SEQ + tok) * DM); v4u* dst = (v4u*)(XS + (eb + sel_before + r) * DM);
        const v4u a = src[lane], c = src[lane + 64]; dst[lane] = a; dst[lane + 64] = c; }
}

__device__ __forceinline__ void p9_final(Frame& F, float* dst_base) {
    const int lane = lane_id();
    const float* MODF = (const float*)(F.ws + WS_MODF); const int* SEL = (const int*)(F.ws + WS_SEL); const bf16* Y = (const bf16*)(F.ws + WS_Y);
    const int gw = F.vcu * NWAVES + F.wave, NGW = F.G * NWAVES;
    for (int m = gw; m < MTOK; m += NGW) {
        const int b = m >> 13;
        GAS f32x4* xr = (GAS f32x4*)(F.out + (size_t)m * DM) + lane;
        f32x4 xv[4], acc[4];
#pragma unroll
        for (int j = 0; j < 4; ++j) { xv[j] = xr[64 * j]; acc[j] = (f32x4){0.f, 0.f, 0.f, 0.f}; }
        const int selv = (lane < NEXP) ? SEL[(size_t)m * NEXP + lane] : -1;
#pragma unroll
        for (int e = 0; e < NEXP; ++e) { const int s = __builtin_amdgcn_readlane(selv, e);
            if (s >= 0) { const GAS v2u* yr = (const GAS v2u*)(Y + ((size_t)(e * 2 + b) * CAP + s) * DM) + lane;
#pragma unroll
                for (int j = 0; j < 4; ++j) { const v2u w = yr[64 * j]; acc[j].x += bflo(w.x); acc[j].y += bfhi(w.x); acc[j].z += bflo(w.y); acc[j].w += bfhi(w.y); } } }
        float ss = 0.f;
#pragma unroll
        for (int j = 0; j < 4; ++j) { const f32x4 gt = *(const f32x4*)(MODF + (size_t)b * 6 * DM + 5 * DM + 4 * lane + 256 * j);
            xv[j] = xv[j] + gt * acc[j]; ss += (xv[j].x * xv[j].x + xv[j].y * xv[j].y) + (xv[j].z * xv[j].z + xv[j].w * xv[j].w); }
        const float rstd = 1.0f / sqrtf(wave_sum(ss) * (1.0f / DM) + EPS_RMS);
#pragma unroll
        for (int j = 0; j < 4; ++j) { const f32x4 gf = *(const f32x4*)(F.g_final + 4 * lane + 256 * j); ((GAS f32x4*)(dst_base + (size_t)m * DM) + lane)[64 * j] = xv[j] * rstd * gf; }
    }
}

struct Args { const float* in[17]; float* out; unsigned char* ws; int ph_lo, ph_hi; };
__global__ void __launch_bounds__(NWAVES * 64, 2) dit_fwd(Args args) {
    extern __shared__ __attribute__((aligned(16))) unsigned char lds[];
    Frame F;
    F.lds = (LAS unsigned char*)lds;
    F.MISC = (volatile LAS unsigned*)(F.lds + MISC_OFF);
    F.wave = __builtin_amdgcn_readfirstlane((int)threadIdx.x >> 6);
    F.G = gridDim.x; { const int bx = blockIdx.x; F.vcu = (F.G % 8 == 0) ? (bx % 8) * (F.G / 8) + bx / 8 : bx; }
    F.ws = args.ws; F.out = args.out; F.ctl = (gu32*)(args.ws + WS_CTL);
    F.x = args.in[0]; F.c = args.in[1]; F.ctx = args.in[2]; F.c_ctx = args.in[3]; F.w_ada = args.in[4]; F.b_ada = args.in[5]; F.g_mix = args.in[6]; F.w_in = args.in[7];
    F.conv_w = args.in[8]; F.sink = args.in[9]; F.w_out = args.in[10]; F.g_ffn = args.in[11]; F.w_router = args.in[12]; F.w_gate = args.in[13]; F.w_up = args.in[14];
    F.w_down = args.in[15]; F.g_final = args.in[16];
    for (int u = ftid(F); u < (LDS_BYTES - LDSCTL_OFF) / 4; u += NWAVES * 64) ((LAS unsigned*)(F.lds + LDSCTL_OFF))[u] = 0u;
    __syncthreads();
    XcdBarrier bar; bar.bar = (unsigned*)(F.ctl + CW_BAR); bar.x = 0; bar.st = nullptr; bar.w = F.wave;
    if (N_LAUNCHES == 1) bar = xcd_barrier_post((unsigned*)(F.ctl + CW_BAR), F.MISC + 8, F.wave);
    const int lo = args.ph_lo, hi = args.ph_hi;
#ifdef DBG_ONLY
#define IN(k) ((k) == DBG_ONLY && lo <= (k) && (k) < hi)
#else
#define IN(k) (lo <= (k) && (k) < hi)
#endif
#define SEAM(k) do { if (IN(k) && IN((k) + 1)) xcd_barrier(bar); } while (0)
#ifdef DBG_DUP
#define REP(k) for (int rep_ = 0; rep_ < ((k) == DBG_DUP ? 2 : 1); ++rep_)
#define REPBAR(k) do { if ((k) == DBG_DUP && rep_ == 0 && N_LAUNCHES == 1) xcd_barrier(bar); } while (0)
#else
#define REP(k)
#define REPBAR(k) do { } while (0)
#endif

    if (IN(0)) { REP(0) { p0_prologue(F); REPBAR(0); } SEAM(0); }
    if (IN(1)) { REP(1) { p1_norm(F); REPBAR(1); } SEAM(1); }
    if (IN(2)) {
        pg8::Gemm g{(const pg8::bf16_t*)(F.ws + WS_XN), (const pg8::bf16_t*)(F.ws + WS_WIN), MALL, INW, DM};
        pg8::InProjOrder S{F.G, (int)blockIdx.x};
        const float* cosT = (const float*)(F.ws + WS_ROPE);
        pg8::EpiInProj E{(pg8::bf16_t*)(F.ws + WS_Q), (pg8::bf16_t*)(F.ws + WS_K), (pg8::bf16_t*)(F.ws + WS_VT), (pg8::bf16_t*)(F.ws + WS_BG), cosT, cosT + 128 * 16};
        static_assert(WS_CG == WS_BG + (size_t)MTOK * CONVW * 2 && WS_HV == WS_CG + (size_t)MTOK * CONVW * 2, "bg | cg | hv contiguous");
        REP(2) { pg8::gemm_phase<pg8::EpiInProj, pg8::InProjOrder, PG8_ALIGN, PG8_SP2>(F.lds + RING_OFF, g, S, E, F.wave); REPBAR(2); }
        SEAM(2);
    }
    if (IN(3)) { REP(3) { p3_attn_conv(F); REPBAR(3); } SEAM(3); }
    if (IN(4)) {
        pg8::Gemm g{(const pg8::bf16_t*)(F.ws + WS_MIX), (const pg8::bf16_t*)(F.ws + WS_WO), MTOK, DM, DM};
        pg8::StaticOrder S; S.init(MTOK, DM, F.G, (int)blockIdx.x);
        pg8::EpiOutProj E{F.x, F.out, (const float*)(F.ws + WS_MODF)};
        REP(4) { pg8::gemm_phase<pg8::EpiOutProj, pg8::StaticOrder, PG8_ALIGN, PG8_SP2>(F.lds + RING_OFF, g, S, E, F.wave); REPBAR(4); }
        SEAM(4);
    }
    if (IN(5)) { REP(5) { p5_norm_router(F); REPBAR(5); } SEAM(5); }
    if (IN(6)) { REP(6) { for (int task = F.vcu; task < BATCH * NEXP * 8; task += F.G) p6_topk_task(F, task); REPBAR(6); } SEAM(6); }
    if (IN(7)) {
        pg8::Gemm g{(const pg8::bf16_t*)(F.ws + WS_XS), (const pg8::bf16_t*)(F.ws + WS_WGU), NEXP * 2 * CAP, NEXP * 2 * DEXP, DM};
        pg8::MoeOrder<8> S{F.G, (int)blockIdx.x};
        pg8::EpiGateUp E{(pg8::bf16_t*)(F.ws + WS_ACT)};
        REP(7) { pg8::gemm_phase<pg8::EpiGateUp, pg8::MoeOrder<8>, PG8_ALIGN, PG8_SP2>(F.lds + RING_OFF, g, S, E, F.wave); REPBAR(7); }
        SEAM(7);
    }
    if (IN(8)) {
        pg8::Gemm g{(const pg8::bf16_t*)(F.ws + WS_ACT), (const pg8::bf16_t*)(F.ws + WS_WD), NEXP * 2 * CAP, NEXP * DM, DEXP};
        pg8::MoeOrder<4> S{F.G, (int)blockIdx.x};
        pg8::EpiDown E{(pg8::bf16_t*)(F.ws + WS_Y), (const float*)(F.ws + WS_GSEL)};
        REP(8) { pg8::gemm_phase<pg8::EpiDown, pg8::MoeOrder<4>, PG8_ALIGN, PG8_SP2>(F.lds + RING_OFF, g, S, E, F.wave); REPBAR(8); }
        SEAM(8);
    }
#if defined(DBG_DUP) && DBG_DUP == 9
    if (IN(9)) { p9_final(F, (float*)(F.ws + WS_WGU)); xcd_barrier(bar); p9_final(F, F.out); }
#elif defined(DBG_DUP) && DBG_DUP == 10
    if (IN(9)) { for (int i = 0; i < 8; ++i) xcd_barrier(bar); p9_final(F, F.out); }
#else
    if (IN(9)) { p9_final(F, F.out); }
#endif
#undef IN
#undef SEAM
}

extern "C" void kernel_launch(void* const* d_in, const int* in_sizes, int n_in, void* d_out, int out_size, void* d_ws, size_t ws_size, hipStream_t stream) {
    static int grid = 0;
    if (grid == 0) {
        if (n_in != 17 || in_sizes[0] != MTOK * DM || out_size != MTOK * DM || ws_size < WS_END) { fprintf(stderr, "kernel_launch: unexpected shapes (n_in %d, in0 %d, out %d, ws %zu); nothing launched\n", n_in, n_in > 0 ? in_sizes[0] : -1, out_size, ws_size); grid = -1; return; }
        int dev = 0, cus = 0, per_cu = 0;
        if (hipGetDevice(&dev) != hipSuccess || hipDeviceGetAttribute(&cus, hipDeviceAttributeMultiprocessorCount, dev) != hipSuccess) { fprintf(stderr, "kernel_launch: device query failed\n"); grid = -1; return; }
        if (hipFuncSetAttribute((const void*)dit_fwd, hipFuncAttributeMaxDynamicSharedMemorySize, LDS_BYTES) != hipSuccess) { fprintf(stderr, "kernel_launch: hipFuncSetAttribute failed\n"); grid = -1; return; }
        if (hipOccupancyMaxActiveBlocksPerMultiprocessor(&per_cu, (const void*)dit_fwd, NWAVES * 64, LDS_BYTES) != hipSuccess || per_cu < 1) { fprintf(stderr, "kernel_launch: occupancy query reports %d workgroups per CU\n", per_cu); per_cu = 1; }
        (void)hipGetLastError();
        grid = cus;
    }
    if (grid < 0) return;
    (void)hipMemsetAsync((char*)d_ws + WS_CTL, 0, CTL_ZERO_BYTES, stream);
    Args a{};
    for (int i = 0; i < 17; ++i) a.in[i] = (const float*)d_in[i];
    a.out = (float*)d_out; a.ws = (unsigned char*)d_ws;
    if (N_LAUNCHES == 1) { a.ph_lo = 0; a.ph_hi = NPH; hipLaunchKernelGGL(dit_fwd, dim3(grid), dim3(NWAVES * 64), LDS_BYTES, stream, a); }
    else for (int li = 0; li < NPH; ++li) { a.ph_lo = li; a.ph_hi = li + 1; hipLaunchKernelGGL(dit_fwd, dim3(grid), dim3(NWAVES * 64), LDS_BYTES, stream, a); }
}
```

```cpp
#include <hip/hip_runtime.h>
#include <cstdio>
#include <cstdint>
namespace pg8 {
#define PG8_LAS __attribute__((address_space(3)))
typedef unsigned short bf16_t;
typedef short bf16x8 __attribute__((ext_vector_type(8)));
typedef float f32x4 __attribute__((ext_vector_type(4)));
typedef unsigned u32x4 __attribute__((ext_vector_type(4)));
constexpr int BM = 256, BK = 64, HALF = 128, HTB = HALF * BK * 2  , STAGE_BYTES = 8 * HTB, NXCD = 8, WGM = 8;

__host__ __device__ __forceinline__ int lds_byte(int r, int c) { const int st = (r >> 4) * 2 + (c >> 5), rr = r & 15, cc = c & 31, ob = rr * 64 + cc * 2; return st * 1024 + (ob ^ (((ob >> 9) & 1) << 5)); }
__host__ __device__ __forceinline__ void stage_rc(int b, int& R, int& C) { const int st = b / 1024, sb = b % 1024, swz = sb ^ (((sb >> 9) & 1) << 5); R = (st >> 1) * 16 + swz / 64; C = (st & 1) * 32 + (swz % 64) / 2; }
__host__ __device__ __forceinline__ int perm32(int rho) { const int n = rho >> 4, i = rho & 15; return 8 * (i >> 2) + 4 * n + (i & 3); }

struct Unit { int pm, pn; };
struct Gemm { const bf16_t* A; const bf16_t* Bt; int M, N, K; };

struct StaticOrder {
    int nM, nN, nwg, G, c;
    __host__ __device__ void init(int M, int N, int G_, int c_) { nM = M / BM; nN = N / BM; nwg = nM * nN; G = G_; c = c_; }
    __host__ __device__ bool next(int i, Unit& u) const {
        const long L = (long)i * G + c; if (L >= nwg) return false;
        int wgid = (int)L; { const int q = nwg / NXCD, r = nwg % NXCD, xcd = wgid % NXCD, off = wgid / NXCD; wgid = (xcd < r ? xcd * (q + 1) : r * (q + 1) + (xcd - r) * q) + off; }
        const int nig = WGM * nN, gid = wgid / nig, fm = gid * WGM, gsz = (nM - fm) < WGM ? (nM - fm) : WGM;
        u.pm = fm + ((wgid % nig) % gsz); u.pn = (wgid % nig) / gsz; return true;
    }
    __device__ __forceinline__ void a_ready(const Unit&) const {}
    __device__ __forceinline__ void done(const Unit&) const {}
};

__device__ __forceinline__ unsigned cvt_pk_bf16(float lo, float hi) { unsigned r; asm volatile("v_cvt_pk_bf16_f32 %0, %1, %2" : "=v"(r) : "v"(lo), "v"(hi)); return r; }
__device__ __forceinline__ int pg8_lane() { int l; asm volatile("v_mbcnt_lo_u32_b32 %0, -1, 0\n\tv_mbcnt_hi_u32_b32 %0, -1, %0" : "=v"(l)); return l; }
template <class Epi, class Sched, bool ALIGN_EPI = false, bool SP2 = false>
__device__ __forceinline__ void gemm_phase(PG8_LAS unsigned char* lds, const Gemm g, const Sched& S, const Epi& E, const int wave_id) {
    const int wid = wave_id, lane = pg8_lane(), tid = wid * 64 + lane, wr = wid >> 2, wc = wid & 3, fr = lane & 15, fq = lane >> 4;
    const int K = g.K, nt = K / BK;
    unsigned voffA[2], voffB[2];
#pragma unroll
    for (int i = 0; i < 2; ++i) { int R, C; stage_rc(tid * 16 + i * 8192, R, C); const int Rb = Epi::PERM ? ((R & ~31) + perm32(R & 31)) : R;
        voffA[i] = (unsigned)(R * K + C) * 2u; voffB[i] = (unsigned)(Rb * K + C) * 2u; }
    const size_t kstep = (size_t)(BK * 2);
    const size_t hstep = (size_t)HALF * K * 2;
    const size_t tstep = 2 * hstep;
    const unsigned ldsw = (unsigned)wid * 1024u;
    const int aoff = lds_byte(wr * 64 + fr, fq * 8), boff = lds_byte(wc * 32 + fr, fq * 8);
#define PG8_SA(b, h) (((b) * 2 + (h)) * HTB)
#define PG8_SB(b, h) ((4 + (b) * 2 + (h)) * HTB)
#define PG8_STAGE(bufoff, gbase, voff) do { _Pragma("unroll") for (int _i = 0; _i < 2; ++_i) \
        __builtin_amdgcn_global_load_lds((const unsigned*)((const char*)(gbase) + (voff)[_i]), (PG8_LAS unsigned*)(lds + (bufoff) + ldsw + _i * 8192), 16, 0, 0); } while (0)
#define PG8_LDA(dst, b, h) do { _Pragma("unroll") for (int m = 0; m < 4; ++m) _Pragma("unroll") for (int k = 0; k < 2; ++k) dst[m][k] = *(const PG8_LAS bf16x8*)(lds + PG8_SA(b, h) + aoff + m * 2048 + k * 1024); } while (0)
#define PG8_LDB(dst, b, h) do { _Pragma("unroll") for (int n = 0; n < 2; ++n) _Pragma("unroll") for (int k = 0; k < 2; ++k) dst[n][k] = *(const PG8_LAS bf16x8*)(lds + PG8_SB(b, h) + boff + n * 2048 + k * 1024); } while (0)
#define PG8_MMA(ai, bj, At, Bt) do { __builtin_amdgcn_s_setprio(1); _Pragma("unroll") for (int m = 0; m < 4; ++m) _Pragma("unroll") for (int n = 0; n < 2; ++n) _Pragma("unroll") for (int k = 0; k < 2; ++k) \
        acc[ai][bj][m][n] = __builtin_amdgcn_mfma_f32_16x16x32_bf16(Bt[n][k], At[m][k], acc[ai][bj][m][n], 0, 0, 0); __builtin_amdgcn_s_setprio(0); } while (0)
#define PG8_WAIT_V(n) asm volatile("s_waitcnt vmcnt(" #n ")" ::: "memory")
#define PG8_WAIT_L(n) asm volatile("s_waitcnt lgkmcnt(" #n ")" ::: "memory")
#define PG8_BAR __builtin_amdgcn_s_barrier()
#define PG8_SCHED __builtin_amdgcn_sched_barrier(0)
    Unit cur, nxt; int ui = 0;
    if (!S.next(0, cur)) return;
    f32x4 acc[2][2][4][2];
#pragma unroll
    for (int a = 0; a < 2; ++a)
#pragma unroll
        for (int b = 0; b < 2; ++b)
#pragma unroll
            for (int m = 0; m < 4; ++m)
#pragma unroll
                for (int n = 0; n < 2; ++n) acc[a][b][m][n] = (f32x4){0.f, 0.f, 0.f, 0.f};
    bf16x8 At[4][2], B0[2][2], B1[2][2];
    const char* cA = (const char*)g.A + (size_t)cur.pm * tstep; const char* cB = (const char*)g.Bt + (size_t)cur.pn * tstep;
    S.a_ready(cur);
    if constexpr (SP2) {
        PG8_STAGE(PG8_SB(0, 0), cB, voffB); PG8_STAGE(PG8_SB(0, 1), cB + hstep, voffB); PG8_STAGE(PG8_SA(0, 0), cA, voffA); PG8_STAGE(PG8_SA(0, 1), cA + hstep, voffA);
        if (wr == 1) PG8_BAR;
        PG8_WAIT_V(2); PG8_BAR;
        PG8_STAGE(PG8_SB(1, 0), cB + kstep, voffB); PG8_STAGE(PG8_SA(1, 0), cA + kstep, voffA); PG8_STAGE(PG8_SB(1, 1), cB + hstep + kstep, voffB);
        PG8_WAIT_V(6); PG8_BAR;
    } else {
        PG8_STAGE(PG8_SB(0, 0), cB, voffB); PG8_STAGE(PG8_SA(0, 0), cA, voffA); PG8_STAGE(PG8_SB(0, 1), cB + hstep, voffB); PG8_STAGE(PG8_SA(0, 1), cA + hstep, voffA);
        if (wr == 1) PG8_BAR;
        PG8_WAIT_V(4); PG8_BAR;
        PG8_STAGE(PG8_SB(1, 0), cB + kstep, voffB); PG8_STAGE(PG8_SA(1, 0), cA + kstep, voffA); PG8_STAGE(PG8_SB(1, 1), cB + hstep + kstep, voffB);
        PG8_WAIT_V(6); PG8_BAR;
    }
    for (;;) {
        const bool has_next = S.next(ui + 1, nxt);
        const char* nA = has_next ? (const char*)g.A + (size_t)nxt.pm * tstep : cA; const char* nB = has_next ? (const char*)g.Bt + (size_t)nxt.pn * tstep : cB;
        for (int t = 0; t < nt; t += 2) {
            const bool last = (t == nt - 2);
            const char* a1 = cA + (size_t)(t + 1) * kstep;
            const char* a2 = last ? nA : cA + (size_t)(t + 2) * kstep; const char* b2 = last ? nB : cB + (size_t)(t + 2) * kstep;
            const char* a3 = a2 + kstep; const char* b3 = b2 + kstep;
            if (last && has_next) S.a_ready(nxt);
            if constexpr (SP2) {
            PG8_LDB(B0, 0, 0); PG8_LDB(B1, 0, 1); PG8_SCHED; PG8_LDA(At, 0, 0); PG8_STAGE(PG8_SA(1, 1), a1 + hstep, voffA);
            PG8_WAIT_V(8); PG8_WAIT_L(0); PG8_BAR; PG8_MMA(0, 0, At, B0); PG8_MMA(0, 1, At, B1); PG8_BAR; PG8_SCHED;
            PG8_LDA(At, 0, 1); PG8_STAGE(PG8_SB(0, 0), b2, voffB); PG8_STAGE(PG8_SB(0, 1), b2 + hstep, voffB); PG8_STAGE(PG8_SA(0, 0), a2, voffA);
            PG8_WAIT_V(8); PG8_WAIT_L(0); PG8_BAR; PG8_MMA(1, 0, At, B0); PG8_MMA(1, 1, At, B1); PG8_BAR; PG8_SCHED;
            PG8_LDB(B0, 1, 0); PG8_LDB(B1, 1, 1); PG8_SCHED; PG8_LDA(At, 1, 0); PG8_STAGE(PG8_SA(0, 1), a2 + hstep, voffA);
            PG8_WAIT_V(8); PG8_WAIT_L(0); PG8_BAR; PG8_MMA(0, 0, At, B0); PG8_MMA(0, 1, At, B1); PG8_BAR; PG8_SCHED;
            PG8_LDA(At, 1, 1); PG8_STAGE(PG8_SB(1, 0), b3, voffB); PG8_STAGE(PG8_SB(1, 1), b3 + hstep, voffB); PG8_STAGE(PG8_SA(1, 0), a3, voffA);
            PG8_WAIT_V(8); PG8_WAIT_L(0); PG8_BAR; PG8_MMA(1, 0, At, B0); PG8_MMA(1, 1, At, B1); PG8_BAR; PG8_SCHED;
            } else {
            PG8_LDB(B0, 0, 0); PG8_SCHED; PG8_LDA(At, 0, 0); PG8_STAGE(PG8_SA(1, 1), a1 + hstep, voffA);
            PG8_WAIT_L(8); PG8_BAR; PG8_WAIT_L(0); PG8_MMA(0, 0, At, B0); PG8_BAR; PG8_SCHED;
            PG8_LDB(B1, 0, 1); PG8_STAGE(PG8_SB(0, 0), b2, voffB);
            PG8_BAR; PG8_WAIT_L(0); PG8_MMA(0, 1, At, B1); PG8_BAR;
            PG8_LDA(At, 0, 1); PG8_STAGE(PG8_SA(0, 0), a2, voffA);
            PG8_BAR; PG8_WAIT_L(0); PG8_MMA(1, 0, At, B0); PG8_BAR; PG8_SCHED;
            PG8_STAGE(PG8_SB(0, 1), b2 + hstep, voffB);
            PG8_WAIT_V(6); PG8_BAR; PG8_MMA(1, 1, At, B1); PG8_BAR;
            PG8_LDB(B0, 1, 0); PG8_SCHED; PG8_LDA(At, 1, 0); PG8_STAGE(PG8_SA(0, 1), a2 + hstep, voffA);
            PG8_WAIT_L(8); PG8_BAR; PG8_WAIT_L(0); PG8_MMA(0, 0, At, B0); PG8_BAR; PG8_SCHED;
            PG8_LDB(B1, 1, 1); PG8_STAGE(PG8_SB(1, 0), b3, voffB);
            PG8_BAR; PG8_WAIT_L(0); PG8_MMA(0, 1, At, B1); PG8_BAR;
            PG8_LDA(At, 1, 1); PG8_STAGE(PG8_SA(1, 0), a3, voffA);
            PG8_BAR; PG8_WAIT_L(0); PG8_MMA(1, 0, At, B0); PG8_BAR; PG8_SCHED;
            PG8_STAGE(PG8_SB(1, 1), b3 + hstep, voffB);
            PG8_WAIT_V(6); PG8_BAR; PG8_MMA(1, 1, At, B1); PG8_BAR;
            }
        }
        if constexpr (ALIGN_EPI) { if (wr == 0) PG8_BAR; }
        if constexpr (!Epi::AFTER_DRAIN) { E(acc, cur, wr, wc, fr, fq); S.done(cur); }
        if (!has_next) break;
#pragma unroll
        for (int a = 0; a < 2; ++a)
#pragma unroll
            for (int b = 0; b < 2; ++b)
#pragma unroll
                for (int m = 0; m < 4; ++m)
#pragma unroll
                    for (int n = 0; n < 2; ++n) acc[a][b][m][n] = (f32x4){0.f, 0.f, 0.f, 0.f};
        cur = nxt; cA = nA; cB = nB; ++ui;
        if constexpr (ALIGN_EPI) { if (wr == 1) PG8_BAR; }
    }
    PG8_WAIT_V(0);
    if constexpr (!ALIGN_EPI) { if (wr == 0) PG8_BAR; }
    PG8_BAR;
    if constexpr (Epi::AFTER_DRAIN) { E.fused(acc, cur, wr, wc, fr, fq, lds, wid, lane); S.done(cur); }
#undef PG8_SA
#undef PG8_SB
#undef PG8_STAGE
#undef PG8_LDA
#undef PG8_LDB
#undef PG8_MMA
#undef PG8_WAIT_V
#undef PG8_WAIT_L
#undef PG8_BAR
#undef PG8_SCHED
}
}

constexpr int BATCH = 2, SEQ = 8192, DM = 1024, MTOK = BATCH * SEQ, CTXL = 256, MCTX = BATCH * CTXL, MALL = MTOK + MCTX;
constexpr int NHEAD = 8, NKVH = 2, HDIM = 64, ATTW = 512, KVW = 128, CONVW = 512, INW = 2304;
constexpr int NEXP = 16, CAP = 1024, DEXP = 1024;
constexpr int KVROWS = CTXL + SEQ;
constexpr float EPS_RMS = 1e-6f;
constexpr float QSCALE = 0.125f * 1.4426950408889634f;

namespace pg8 {
typedef unsigned u32x2 __attribute__((ext_vector_type(2)));
__device__ __forceinline__ float bf2f(unsigned short h) { return __uint_as_float((unsigned)h << 16); }

struct InProjOrder {
    int G, c;
    __device__ bool next(int i, Unit& u) const {
        const int L = i * G + c; constexpr int nM = 64, nN = 9, nwg = nM * nN;
        if (L >= nwg + 2) return false;
        if (L >= nwg) { u.pm = 64 + (L - nwg); u.pn = 2; return true; }
        int wgid = L; { const int q = nwg / NXCD, r = nwg % NXCD, xcd = wgid % NXCD, off = wgid / NXCD; wgid = (xcd < r ? xcd * (q + 1) : r * (q + 1) + (xcd - r) * q) + off; }
        const int nig = WGM * nN, gid = wgid / nig, fm = gid * WGM, gsz = (nM - fm) < WGM ? (nM - fm) : WGM;
        u.pm = fm + ((wgid % nig) % gsz); u.pn = (wgid % nig) / gsz; return true;
    }
    __device__ __forceinline__ void a_ready(const Unit&) const {}
    __device__ __forceinline__ void done(const Unit&) const {}
};
template <int NPE> struct MoeOrder {
    int G, c;
    __device__ bool next(int i, Unit& u) const {
        const int L = i * G + c; constexpr int U = NEXP * 8 * NPE;
        if (L >= U) return false;
        const int id = (L % NXCD) * (U / NXCD) + L / NXCD;
        const int e = id / (8 * NPE), sub = id % (8 * NPE);
        u.pm = e * 8 + (sub & 7); u.pn = e * NPE + (sub >> 3); return true;
    }
    __device__ __forceinline__ void a_ready(const Unit&) const {}
    __device__ __forceinline__ void done(const Unit&) const {}
};

struct EpiInProj {
    static constexpr bool PERM = true, AFTER_DRAIN = false;
    bf16_t *Q, *Kb, *Vt, *BG; const float* cosT; const float* sinT;
    __device__ __forceinline__ void operator()(const f32x4 (&acc)[2][2][4][2], const Unit& u, int wr, int wc, int fr, int fq) const {
        const int row0 = u.pm * BM + wr * 64 + fr;
        if (u.pn >= 3) {
            bf16_t* base = BG + (size_t)((u.pn - 3) >> 1) * ((size_t)MTOK * CONVW);
            const int col0 = ((u.pn - 3) & 1) * 256 + wc * 32 + 8 * fq;
#pragma unroll
            for (int ai = 0; ai < 2; ++ai)
#pragma unroll
                for (int m = 0; m < 4; ++m) { bf16_t* rowp = base + (size_t)(row0 + ai * HALF + m * 16) * CONVW + col0;
#pragma unroll
                    for (int bj = 0; bj < 2; ++bj) { const f32x4 v0 = acc[ai][bj][m][0], v1 = acc[ai][bj][m][1];
                        u32x4 w; w.x = cvt_pk_bf16(v0[0], v0[1]); w.y = cvt_pk_bf16(v0[2], v0[3]); w.z = cvt_pk_bf16(v1[0], v1[1]); w.w = cvt_pk_bf16(v1[2], v1[3]);
                        *(u32x4*)(rowp + bj * HALF) = w; } }
        } else if (u.pn < 2) {
            const int dbase = 16 * (wc & 1) + 4 * fq;
#pragma unroll
            for (int ai = 0; ai < 2; ++ai)
#pragma unroll
                for (int m = 0; m < 4; ++m) { const int r = row0 + ai * HALF + m * 16, t = r & (SEQ - 1), pos = (wc & 1) ? (t & 63) : (t >> 6);
                    const f32x4 cs = *(const f32x4*)(cosT + pos * 16 + 4 * fq), sn = *(const f32x4*)(sinT + pos * 16 + 4 * fq);
#pragma unroll
                    for (int bj = 0; bj < 2; ++bj) { const f32x4 x1 = acc[ai][bj][m][0], x2 = acc[ai][bj][m][1];
                        const f32x4 o1 = (x1 * cs - x2 * sn) * QSCALE, o2 = (x1 * sn + x2 * cs) * QSCALE;
                        bf16_t* p = Q + (size_t)r * ATTW + (u.pn * 4 + bj * 2 + (wc >> 1)) * HDIM + dbase;
                        u32x2 a, b; a.x = cvt_pk_bf16(o1[0], o1[1]); a.y = cvt_pk_bf16(o1[2], o1[3]); b.x = cvt_pk_bf16(o2[0], o2[1]); b.y = cvt_pk_bf16(o2[2], o2[3]);
                        *(u32x2*)p = a; *(u32x2*)(p + 32) = b; }
                    asm volatile("" ::: "memory"); }
        } else {
            const bool is_ctx = u.pm >= MTOK / BM; const int dbase = 16 * (wc & 1) + 4 * fq, kvh = wc >> 1;
#pragma unroll
            for (int ai = 0; ai < 2; ++ai)
#pragma unroll
                for (int m = 0; m < 4; ++m) { const int r = row0 + ai * HALF + m * 16; int b, kvrow; f32x4 o1 = acc[ai][0][m][0], o2 = acc[ai][0][m][1];
                    if (!is_ctx) { b = r >> 13; const int t = r & (SEQ - 1), pos = (wc & 1) ? (t & 63) : (t >> 6); kvrow = CTXL + t;
                        const f32x4 cs = *(const f32x4*)(cosT + pos * 16 + 4 * fq), sn = *(const f32x4*)(sinT + pos * 16 + 4 * fq);
                        const f32x4 x1 = o1, x2 = o2; o1 = x1 * cs - x2 * sn; o2 = x1 * sn + x2 * cs; }
                    else { const int rr = r - MTOK; b = rr >> 8; kvrow = rr & (CTXL - 1); }
                    bf16_t* p = Kb + ((size_t)(b * NKVH + kvh) * KVROWS + kvrow) * HDIM + dbase;
                    u32x2 a, c2; a.x = cvt_pk_bf16(o1[0], o1[1]); a.y = cvt_pk_bf16(o1[2], o1[3]); c2.x = cvt_pk_bf16(o2[0], o2[1]); c2.y = cvt_pk_bf16(o2[2], o2[3]);
                    *(u32x2*)p = a; *(u32x2*)(p + 32) = c2;
                    bf16_t* vp = Vt + ((size_t)(b * NKVH + kvh) * HDIM + 32 * (wc & 1) + 8 * fq) * KVROWS + kvrow;
#pragma unroll
                    for (int n = 0; n < 2; ++n) { const f32x4 v = acc[ai][1][m][n]; const unsigned w0 = cvt_pk_bf16(v[0], v[1]), w1 = cvt_pk_bf16(v[2], v[3]);
                        vp[(size_t)(4 * n + 0) * KVROWS] = (bf16_t)(w0 & 0xffffu); vp[(size_t)(4 * n + 1) * KVROWS] = (bf16_t)(w0 >> 16);
                        vp[(size_t)(4 * n + 2) * KVROWS] = (bf16_t)(w1 & 0xffffu); vp[(size_t)(4 * n + 3) * KVROWS] = (bf16_t)(w1 >> 16); }
                    asm volatile("" ::: "memory"); }
        }
    }
};
struct EpiOutProj {
    static constexpr bool PERM = false, AFTER_DRAIN = false;
    const float* x; float* x1; const float* modf;
    __device__ __forceinline__ void operator()(const f32x4 (&acc)[2][2][4][2], const Unit& u, int wr, int wc, int fr, int fq) const {
        const int row0 = u.pm * BM + wr * 64 + fr, col0 = u.pn * BM + wc * 32 + 4 * fq, b = (u.pm * BM) >> 13;
        f32x4 gt[2][2];
#pragma unroll
        for (int bj = 0; bj < 2; ++bj)
#pragma unroll
            for (int n = 0; n < 2; ++n) gt[bj][n] = *(const f32x4*)(modf + (size_t)b * 6 * DM + 2 * DM + col0 + bj * HALF + n * 16);
#pragma unroll
        for (int ai = 0; ai < 2; ++ai)
#pragma unroll
            for (int m = 0; m < 4; ++m) { const size_t off = (size_t)(row0 + ai * HALF + m * 16) * DM + col0;
#pragma unroll
                for (int bj = 0; bj < 2; ++bj)
#pragma unroll
                    for (int n = 0; n < 2; ++n) { const f32x4 xv = *(const f32x4*)(x + off + bj * HALF + n * 16); *(f32x4*)(x1 + off + bj * HALF + n * 16) = xv + gt[bj][n] * acc[ai][bj][m][n]; } }
    }
};
struct EpiGateUp {
    static constexpr bool PERM = true, AFTER_DRAIN = false;
    bf16_t* act;
    __device__ __forceinline__ void operator()(const f32x4 (&acc)[2][2][4][2], const Unit& u, int wr, int wc, int fr, int fq) const {
        const int row0 = u.pm * BM + wr * 64 + fr, col0 = (u.pn & 7) * HALF + wc * 32 + 8 * fq;
#pragma unroll
        for (int ai = 0; ai < 2; ++ai)
#pragma unroll
            for (int m = 0; m < 4; ++m) { float o[8];
#pragma unroll
                for (int n = 0; n < 2; ++n)
#pragma unroll
                    for (int i = 0; i < 4; ++i) { const float g = acc[ai][0][m][n][i], up = acc[ai][1][m][n][i];
                        o[4 * n + i] = g * up * __builtin_amdgcn_rcpf(1.0f + __builtin_amdgcn_exp2f(-1.4426950408889634f * g)); }
                u32x4 w; w.x = cvt_pk_bf16(o[0], o[1]); w.y = cvt_pk_bf16(o[2], o[3]); w.z = cvt_pk_bf16(o[4], o[5]); w.w = cvt_pk_bf16(o[6], o[7]);
                *(u32x4*)(act + (size_t)(row0 + ai * HALF + m * 16) * DEXP + col0) = w; }
    }
};
struct EpiDown {
    static constexpr bool PERM = true, AFTER_DRAIN = false;
    bf16_t* y; const float* gsel;
    __device__ __forceinline__ void operator()(const f32x4 (&acc)[2][2][4][2], const Unit& u, int wr, int wc, int fr, int fq) const {
        const int row0 = u.pm * BM + wr * 64 + fr, col0 = (u.pn & 3) * BM + wc * 32 + 8 * fq;
#pragma unroll
        for (int ai = 0; ai < 2; ++ai)
#pragma unroll
            for (int m = 0; m < 4; ++m) { const int r = row0 + ai * HALF + m * 16; const float g = gsel[r];
#pragma unroll
                for (int bj = 0; bj < 2; ++bj) { const f32x4 v0 = acc[ai][bj][m][0] * g, v1 = acc[ai][bj][m][1] * g;
                    u32x4 w; w.x = cvt_pk_bf16(v0[0], v0[1]); w.y = cvt_pk_bf16(v0[2], v0[3]); w.z = cvt_pk_bf16(v1[0], v1[1]); w.w = cvt_pk_bf16(v1[2], v1[3]);
                    *(u32x4*)(y + (size_t)r * DM + col0 + bj * HALF) = w; } }
    }
};
}
#ifndef PG8_SP2
#define PG8_SP2 true
#endif
#ifndef PG8_ALIGN
#define PG8_ALIGN true
#endif

constexpr int NWAVES = 8;
constexpr int NPH = 10;
#ifndef MK_N_LAUNCHES
#define MK_N_LAUNCHES 1
#endif
constexpr int N_LAUNCHES = MK_N_LAUNCHES;
static_assert(N_LAUNCHES == 1 || N_LAUNCHES == NPH, "MK_N_LAUNCHES is 1 or 10");

constexpr size_t MiB = 1u << 20;
constexpr size_t WS_CTL = 0, CTL_ZERO_BYTES = 64 * 1024;
constexpr size_t WS_MODP = 1 * MiB;
constexpr size_t WS_MODF = 2 * MiB + 512 * 1024;
constexpr size_t WS_ROPE = 2 * MiB + 768 * 1024;
constexpr size_t WS_AFF = 3 * MiB;
constexpr size_t WS_GSEL = 4 * MiB;
constexpr size_t WS_SEL = 5 * MiB;
constexpr size_t WS_WIN = 6 * MiB, WS_WO = 11 * MiB;
constexpr size_t WS_WGU = 16 * MiB, WS_WD = 80 * MiB;
constexpr size_t WS_XN = 112 * MiB;
constexpr size_t WS_MIX = 112 * MiB;
constexpr size_t WS_H2 = 146 * MiB;
constexpr size_t WS_ACT = 112 * MiB;
constexpr size_t WS_Q = 178 * MiB, WS_K = 194 * MiB, WS_VT = 198 * MiB + 512 * 1024, WS_BG = 203 * MiB, WS_CG = 219 * MiB, WS_HV = 235 * MiB;
constexpr size_t WS_XS = 178 * MiB;
constexpr size_t WS_Y = 178 * MiB;
constexpr size_t WS_END = 251 * MiB;
static_assert(WS_K + (size_t)BATCH * NKVH * KVROWS * HDIM * 2 <= WS_VT && WS_VT + (size_t)BATCH * NKVH * KVROWS * HDIM * 2 <= WS_BG, "K / V^T buffers");
static_assert(WS_XN + (size_t)MALL * DM * 2 <= WS_H2 && WS_H2 + (size_t)MTOK * DM * 2 <= WS_Q && WS_XS + (size_t)NEXP * 2 * CAP * DM * 2 <= WS_END, "d_ws map");
constexpr int CW_BAR = 1024;
constexpr int RING_OFF = 0, RING_BYTES = 131072;
constexpr int LDSCTL_OFF = RING_BYTES, MISC_OFF = LDSCTL_OFF + 320;
constexpr int LDS_BYTES = 147456;

#define GAS __attribute__((address_space(1)))
#define LAS __attribute__((address_space(3)))
typedef unsigned short bf16;
typedef unsigned v4u __attribute__((ext_vector_type(4)));
typedef unsigned v2u __attribute__((ext_vector_type(2)));
typedef float f32x4 __attribute__((ext_vector_type(4)));
typedef float f32x16 __attribute__((ext_vector_type(16)));
typedef short bf16x8 __attribute__((ext_vector_type(8)));
typedef GAS unsigned gu32;
#define RLX_AGENT __ATOMIC_RELAXED, __HIP_MEMORY_SCOPE_AGENT
#define LDS_WAIT() asm volatile("s_waitcnt lgkmcnt(0)" ::: "memory")
#define VM_WAIT() asm volatile("s_waitcnt vmcnt(0)" ::: "memory")
__device__ __forceinline__ unsigned f2bf(float f) { unsigned u = __builtin_bit_cast(unsigned, f); return (u + 0x7fffu + ((u >> 16) & 1u)) >> 16; }
__device__ __forceinline__ unsigned pk2(float lo, float hi) { return f2bf(lo) | (f2bf(hi) << 16); }
__device__ __forceinline__ float bflo(unsigned w) { return __uint_as_float(w << 16); }
__device__ __forceinline__ float bfhi(unsigned w) { return __uint_as_float(w & 0xffff0000u); }
#define XB_TMO      128
#define XB_XCNT(j)  (256  + 64 * (j))
#define XB_XSUB(j)  (1280 + 64 * (j))
#define XB_XGEN(j)  (2304 + 64 * (j))
#define XB_TOP      3328
#define XB_TOPGEN   3392
#define XCD_BAR_WORDS 3456
#define XB_SPIN_CAP (1u << 18)

__device__ __forceinline__ unsigned xb_ld(unsigned* p)              { return __hip_atomic_load(p, __ATOMIC_RELAXED, __HIP_MEMORY_SCOPE_AGENT); }
__device__ __forceinline__ unsigned xb_add(unsigned* p, unsigned v) { return __hip_atomic_fetch_add(p, v, __ATOMIC_RELAXED, __HIP_MEMORY_SCOPE_AGENT); }
__device__ __forceinline__ unsigned xb_xcc_id() { return (unsigned)__builtin_amdgcn_s_getreg((3 << 11) | 20) & 0xFu; }
#define XB_SPIN(cond, bar) do { unsigned _sp = 0; while (cond) { __builtin_amdgcn_s_sleep(1); \
    if ((++_sp & 255u) == 0u) { if (xb_ld(&(bar)[XB_TMO])) break; if (_sp > XB_SPIN_CAP) { atomicAdd(&(bar)[XB_TMO], 1u); break; } } } } while (0)

struct XcdBarrier {
    unsigned* bar; unsigned x;
    volatile LAS unsigned* st;
    int w;
};

__device__ __forceinline__ int xb_lane() { int l; asm volatile("v_mbcnt_lo_u32_b32 %0, -1, 0\n\tv_mbcnt_hi_u32_b32 %0, -1, %0" : "=v"(l)); return l; }
#define MY_TID0() (b.w == 0 && xb_lane() == 0)
__device__ __forceinline__ XcdBarrier xcd_barrier_post(unsigned* bar, volatile LAS unsigned* st, int w) {
    XcdBarrier b; b.bar = bar; b.x = xb_xcc_id(); b.st = st; b.w = w;
    if (MY_TID0()) (void)xb_add(&bar[XB_XCNT(b.x)], 1u);
    return b;
}
__device__ __forceinline__ void xcd_barrier_complete(unsigned* bar, unsigned x, unsigned& nloc, unsigned& nx) {
    const unsigned G = gridDim.x * gridDim.y * gridDim.z;
    unsigned sum, cnt, mine, sp = 0u;
    for (;;) {
        sum = 0u; cnt = 0u; mine = 0u;
#pragma unroll
        for (unsigned j = 0; j < 16; ++j) { const unsigned c = xb_ld(&bar[XB_XCNT(j)]); sum += c; cnt += (c > 0u) ? 1u : 0u; mine = (j == x) ? c : mine; }
        if (sum == G) break;
        __builtin_amdgcn_s_sleep(1);
        if ((++sp & 255u) == 0u) { if (xb_ld(&bar[XB_TMO])) break; if (sp > XB_SPIN_CAP) { atomicAdd(&bar[XB_TMO], 1u); break; } }
    }
    nloc = mine > 0u ? mine : 1u; nx = cnt > 0u ? cnt : 1u;
}

__device__ __forceinline__ void xcd_barrier(const XcdBarrier& b) {
    asm volatile("s_waitcnt vmcnt(0)" ::: "memory");
    __syncthreads();
    if (MY_TID0()) {
        unsigned* bar = b.bar;
        __builtin_amdgcn_s_waitcnt(0);
        unsigned nloc = b.st[0], nx = b.st[1];
        if (nloc == 0u) { xcd_barrier_complete(bar, b.x, nloc, nx); b.st[0] = nloc; b.st[1] = nx; }
        const unsigned old = xb_add(&bar[XB_XSUB(b.x)], 1u);
        const unsigned gen = old / nloc;
        if (old + 1u == (gen + 1u) * nloc) {
            __builtin_amdgcn_fence(__ATOMIC_RELEASE, "agent");
            asm volatile("s_waitcnt vmcnt(0)" ::: "memory");
            const unsigned og = xb_add(&bar[XB_TOP], 1u);
            const unsigned tg = og / nx;
            if (og + 1u == (tg + 1u) * nx) xb_add(&bar[XB_TOPGEN], 1u);
            else XB_SPIN(xb_ld(&bar[XB_TOPGEN]) == tg, bar);
            __builtin_amdgcn_fence(__ATOMIC_ACQUIRE, "agent");
            xb_add(&bar[XB_XGEN(b.x)], 1u);
            asm volatile("s_waitcnt vmcnt(0)" ::: "memory");
        } else {
            XB_SPIN(xb_ld(&bar[XB_XGEN(b.x)]) == gen, bar);
            __builtin_amdgcn_fence(__ATOMIC_ACQUIRE, "agent");
            asm volatile("s_waitcnt vmcnt(0)" ::: "memory");
        }
    }
    __syncthreads();
}

__device__ __forceinline__ int lane_id() { int l; asm volatile("v_mbcnt_lo_u32_b32 %0, -1, 0\n\tv_mbcnt_hi_u32_b32 %0, -1, %0" : "=v"(l)); return l; }
struct Frame {
    LAS unsigned char* lds;
    volatile LAS unsigned* MISC;
    gu32* ctl;
    int wave, vcu, G;
    const float *x, *c, *ctx, *c_ctx, *w_ada, *b_ada, *g_mix, *w_in, *conv_w, *sink, *w_out, *g_ffn, *w_router, *w_gate, *w_up, *w_down, *g_final;
    float* out; unsigned char* ws;
};
__device__ __forceinline__ int ftid(const Frame& F) { return F.wave * 64 + lane_id(); }
__device__ __forceinline__ float wave_sum(float v) {
#pragma unroll
    for (int o = 1; o < 64; o <<= 1) v += __shfl_xor(v, o);
    return v;
}
typedef float f32x2_t __attribute__((ext_vector_type(2))); typedef __bf16 bf16x2_t __attribute__((ext_vector_type(2)));
__device__ __forceinline__ unsigned cvtpk(float lo, float hi) { f32x2_t v = {lo, hi}; bf16x2_t b = __builtin_convertvector(v, bf16x2_t); return __builtin_bit_cast(unsigned, b); }

template <int MODE> __device__ __forceinline__ int wt_row(int n, int row_off) {
    if (MODE == 0) return row_off + n;
    if (MODE == 1) { if (n >= ATTW + KVW) return n; const int d = n & 63; return (n & ~63) + 8 * ((d & 31) >> 2) + 4 * (d >> 5) + (d & 3); }
    return row_off + (n >> 7) * 256 + (n & 127) + (MODE == 3 ? 128 : 0);
}
template <int MODE> __device__ __forceinline__ void p0_transpose_item(const float* W, int K, int N, bf16* WT, int row_off, LAS float* scr, int item, int lane) {
    const int nblk = N / 32, kb = item / nblk, nb = item % nblk, k0 = 64 * kb, n0 = 32 * nb;
#pragma unroll 8
    for (int i = 0; i < 32; ++i) { const int kk = 2 * i + (lane >> 5); scr[kk * 33 + (lane & 31)] = W[(size_t)(k0 + kk) * N + n0 + (lane & 31)]; }
    LDS_WAIT(); asm volatile("" ::: "memory");
    const int c = lane & 7;
#pragma unroll
    for (int j = 0; j < 4; ++j) { const int n = (lane >> 3) + 8 * j; const LAS float* s = scr + (8 * c) * 33 + n;
        v4u o; o.x = pk2(s[0 * 33], s[1 * 33]); o.y = pk2(s[2 * 33], s[3 * 33]); o.z = pk2(s[4 * 33], s[5 * 33]); o.w = pk2(s[6 * 33], s[7 * 33]);
        *(GAS v4u*)(WT + (size_t)wt_row<MODE>(n0 + n, row_off) * K + k0 + 8 * c) = o; }
    LDS_WAIT(); asm volatile("" ::: "memory");
}
__device__ __forceinline__ void p0_prologue(Frame& F) {
    const int lane = lane_id(), tid = F.wave * 64 + lane;
    LAS float* sil = (LAS float*)(F.lds + LDSCTL_OFF + 1024);
    float* MODP = (float*)(F.ws + WS_MODP);
    for (int task = F.vcu; task < 192; task += F.G) {
        const int kc = task / 12, jb = task % 12;
        __syncthreads();
        if (tid < 192) { const int v = tid >> 6, k = kc * 64 + (tid & 63); const float cv = (v < 2) ? F.c[v * DM + k] : F.c_ctx[k]; sil[tid] = cv / (1.0f + __expf(-cv)); }
        __syncthreads();
        const int j = jb * 512 + tid; const float* wp = F.w_ada + (size_t)(kc * 64) * (6 * DM) + j; float a0 = 0.f, a1 = 0.f, a2 = 0.f;
#pragma unroll 16
        for (int kk = 0; kk < 64; ++kk) { const float w = wp[(size_t)kk * (6 * DM)]; a0 += sil[kk] * w; a1 += sil[64 + kk] * w; a2 += sil[128 + kk] * w; }
        MODP[(size_t)(kc * 3 + 0) * (6 * DM) + j] = a0; MODP[(size_t)(kc * 3 + 1) * (6 * DM) + j] = a1; MODP[(size_t)(kc * 3 + 2) * (6 * DM) + j] = a2;
    }
    if (F.vcu == (192 % F.G)) {
        float* cosT = (float*)(F.ws + WS_ROPE); float* sinT = cosT + 128 * 16;
        for (int i = tid; i < 2048; i += NWAVES * 64) { const int pos = i >> 4, f = i & 15;
            const double b4 = (f & 3) == 0 ? 1.0 : ((f & 3) == 1 ? 0.5623413251903491 : ((f & 3) == 2 ? 0.31622776601683794 : 0.1778279410038923));
            const double p10 = (f >> 2) == 0 ? 1.0 : ((f >> 2) == 1 ? 0.1 : ((f >> 2) == 2 ? 0.01 : 0.001));
            const double ang = (double)pos * (b4 * p10); const double kq = __builtin_rint(ang * 0.6366197723675814);
            const double r = (ang - kq * 1.5707963267948966) - kq * 6.123233995736766e-17; const int q = ((int)kq) & 3; const double r2 = r * r;
            const double s = r * (1.0 + r2 * (-1.0 / 6 + r2 * (1.0 / 120 + r2 * (-1.0 / 5040 + r2 * (1.0 / 362880 + r2 * (-1.0 / 39916800 + r2 * (1.0 / 6227020800.0)))))));
            const double c = 1.0 + r2 * (-0.5 + r2 * (1.0 / 24 + r2 * (-1.0 / 720 + r2 * (1.0 / 40320 + r2 * (-1.0 / 3628800 + r2 * (1.0 / 479001600.0 + r2 * (-1.0 / 87178291200.0)))))));
            const double cc = q == 0 ? c : (q == 1 ? -s : (q == 2 ? -c : s)), ss = q == 0 ? s : (q == 1 ? c : (q == 2 ? -s : -c));
            cosT[i] = (float)cc; sinT[i] = (float)ss; }
    }
    __syncthreads();
    LAS float* scr = (LAS float*)(F.lds + RING_OFF + F.wave * 16384);
    const int gw = F.vcu * NWAVES + F.wave, NGW = F.G * NWAVES;
    constexpr int I_IN = (DM / 64) * (INW / 32), I_O = (DM / 64) * (DM / 32), I_E = (DM / 64) * (DEXP / 32);
    constexpr int NITEMS = I_IN + I_O + 3 * NEXP * I_E;
    bf16* WIN = (bf16*)(F.ws + WS_WIN); bf16* WO = (bf16*)(F.ws + WS_WO); bf16* WGU = (bf16*)(F.ws + WS_WGU); bf16* WD = (bf16*)(F.ws + WS_WD);
    for (int it = gw; it < NITEMS; it += NGW) {
        int r = it;
        if (r < I_IN) { p0_transpose_item<1>(F.w_in, DM, INW, WIN, 0, scr, r, lane); continue; } r -= I_IN;
        if (r < I_O) { p0_transpose_item<0>(F.w_out, DM, DM, WO, 0, scr, r, lane); continue; } r -= I_O;
        const int mat = r / (NEXP * I_E), rr = r % (NEXP * I_E), e = rr / I_E, ie = rr % I_E;
        if (mat == 0) p0_transpose_item<2>(F.w_gate + (size_t)e * DM * DEXP, DM, DEXP, WGU, e * 2 * DEXP, scr, ie, lane);
        else if (mat == 1) p0_transpose_item<3>(F.w_up + (size_t)e * DM * DEXP, DM, DEXP, WGU, e * 2 * DEXP, scr, ie, lane);
        else p0_transpose_item<0>(F.w_down + (size_t)e * DEXP * DM, DEXP, DM, WD, e * DM, scr, ie, lane);
    }
}

__device__ __forceinline__ float mod_sum(const float* MODP, const float* b_ada, int v, int col) {
    float s = b_ada[col];
#pragma unroll
    for (int kc = 0; kc < 16; ++kc) s += MODP[(size_t)(kc * 3 + v) * (6 * DM) + col];
    return s;
}
__device__ __forceinline__ void p1_norm(Frame& F) {
    const int lane = lane_id(), tid = F.wave * 64 + lane;
    const float* MODP = (const float*)(F.ws + WS_MODP); float* MODF = (float*)(F.ws + WS_MODF);
    LAS float* tA = (LAS float*)(F.lds); LAS float* tB = tA + 3 * DM;
    for (int idx = tid; idx < 3 * 2 * DM; idx += NWAVES * 64) { const int v = idx / (2 * DM), q = idx % (2 * DM); const float s = mod_sum(MODP, F.b_ada, v, q);
        if (q < DM) tB[v * DM + q] = s; else tA[v * DM + q - DM] = F.g_mix[q - DM] * (1.0f + s); }
    for (int o = F.vcu * (NWAVES * 64) + tid; o < 3 * 6 * DM; o += F.G * NWAVES * 64) MODF[o] = mod_sum(MODP, F.b_ada, o / (6 * DM), o % (6 * DM));
    __syncthreads();
    bf16* XN = (bf16*)(F.ws + WS_XN);
    const int gw = F.vcu * NWAVES + F.wave, NGW = F.G * NWAVES;
    for (int m = gw; m < MALL; m += NGW) {
        const int v = m < SEQ ? 0 : (m < MTOK ? 1 : 2);
        const float* src = m < MTOK ? F.x + (size_t)m * DM : F.ctx + (size_t)(m - MTOK) * DM;
        const GAS f32x4* xr = (const GAS f32x4*)src + lane;
        f32x4 xv[4]; float ss = 0.f;
#pragma unroll
        for (int j = 0; j < 4; ++j) { xv[j] = xr[64 * j]; ss += (xv[j].x * xv[j].x + xv[j].y * xv[j].y) + (xv[j].z * xv[j].z + xv[j].w * xv[j].w); }
        const float rstd = 1.0f / sqrtf(wave_sum(ss) * (1.0f / DM) + EPS_RMS);
        GAS unsigned long long* o8 = (GAS unsigned long long*)(XN + (size_t)m * DM) + lane;
#pragma unroll
        for (int j = 0; j < 4; ++j) { const f32x4 a = *(const LAS f32x4*)(tA + v * DM + 4 * lane + 256 * j), sh = *(const LAS f32x4*)(tB + v * DM + 4 * lane + 256 * j);
            const f32x4 h = xv[j] * rstd * a + sh;
            o8[64 * j] = (unsigned long long)cvtpk(h.x, h.y) | ((unsigned long long)cvtpk(h.z, h.w) << 32); }
    }
}

#define MFMA32(a, b, c) __builtin_amdgcn_mfma_f32_32x32x16_bf16((a), (b), (c), 0, 0, 0)
__device__ __forceinline__ int crow(int r, int hi) { return (r & 3) + 8 * (r >> 2) + 4 * hi; }
__device__ __forceinline__ bf16x8 pack8(const f32x16& p, int s) {
    v4u w; w.x = cvtpk(p[8 * s + 0], p[8 * s + 1]); w.y = cvtpk(p[8 * s + 2], p[8 * s + 3]); w.z = cvtpk(p[8 * s + 4], p[8 * s + 5]); w.w = cvtpk(p[8 * s + 6], p[8 * s + 7]);
    return __builtin_bit_cast(bf16x8, w);
}
constexpr int ATT_KBUF = 0, ATT_VBUF = 8192, ATT_BUF = 16384;
__device__ __forceinline__ void attn_unit(Frame& F, int u) {
    const int b = u >> 7, kvh = (u >> 6) & 1, n = u & 63;
    const int lane = lane_id(), tid = F.wave * 64 + lane, r32 = lane & 31, hh = lane >> 5, g = F.wave >> 1, half = F.wave & 1, h = kvh * 4 + g;
    const bf16* Q = (const bf16*)(F.ws + WS_Q); bf16* MIX = (bf16*)(F.ws + WS_MIX);
    const bf16* Kbase = (const bf16*)(F.ws + WS_K) + (size_t)(b * NKVH + kvh) * KVROWS * HDIM;
    const bf16* Vbase = (const bf16*)(F.ws + WS_VT) + (size_t)(b * NKVH + kvh) * HDIM * KVROWS;
    const float sk2 = F.sink[h] * 1.4426950408889634f;
    const int q0 = n * 128 + half * 64;
    const int ntiles = (n == 0 || n == SEQ / 128 - 1) ? 8 : 10, tskip = (n == 0) ? 2 : 0;
    const int srow = tid >> 3, sc = tid & 7;
    const unsigned kw_off = (unsigned)(srow * 128 + ((sc ^ ((srow >> 1) & 7)) << 4));
    const int vg = (srow >> 1) & 15; const unsigned vw_off = (unsigned)(srow * 128 + ((sc ^ (vg >> 1)) << 4)); const bool vswap = (vg & 1) != 0;
    v4u kreg, vreg;
#define ATT_TILE_ROW(idx) (((idx) < 4) ? (idx) * 64 : CTXL + n * 128 - 128 + ((idx) + tskip - 4) * 64)
#define ATT_LOAD(idx) do { const int kr_ = ATT_TILE_ROW(idx); kreg = *(const v4u*)(Kbase + (size_t)kr_ * HDIM + tid * 8); vreg = *(const v4u*)(Vbase + (size_t)srow * KVROWS + kr_ + sc * 8); } while (0)
#define ATT_STORE(bufi) do { LAS unsigned char* tb_ = F.lds + (bufi) * ATT_BUF; *(LAS v4u*)(tb_ + ATT_KBUF + kw_off) = kreg; \
        v4u vv_ = vreg; if (vswap) { vv_.x = vreg.z; vv_.y = vreg.w; vv_.z = vreg.x; vv_.w = vreg.y; } *(LAS v4u*)(tb_ + ATT_VBUF + vw_off) = vv_; } while (0)
    __syncthreads();
    ATT_LOAD(0);
    LAS unsigned char* qlds = F.lds + 2 * ATT_BUF + F.wave * 8192 + lane * 16;
#pragma unroll
    for (int sb = 0; sb < 2; ++sb)
#pragma unroll
        for (int s = 0; s < 4; ++s) *(LAS bf16x8*)(qlds + (sb * 4 + s) * 1024) = *(const bf16x8*)(Q + (size_t)(b * SEQ + q0 + sb * 32 + r32) * ATTW + h * HDIM + 16 * s + 8 * hh);
    f32x16 o[2][2]; float mrun[2], lrun[2];
#pragma unroll
    for (int sb = 0; sb < 2; ++sb) { mrun[sb] = sk2; lrun[sb] = hh == 0 ? 1.0f : 0.0f;
#pragma unroll
        for (int db = 0; db < 2; ++db)
#pragma unroll
            for (int i = 0; i < 16; ++i) o[sb][db][i] = 0.f; }
    ATT_STORE(0);
    __syncthreads();
    unsigned kro[2];
#pragma unroll
    for (int kb = 0; kb < 2; ++kb) { const int row = kb * 32 + r32; kro[kb] = (unsigned)(ATT_KBUF + row * 128); }
    const int ksw = (r32 >> 1) & 7;
    const int vsw = (r32 >> 1) & 15;
    for (int idx = 0; idx < ntiles; ++idx) {
        const int cur = idx & 1;
        if (idx + 1 < ntiles) ATT_LOAD(idx + 1);
        const LAS unsigned char* tb = F.lds + cur * ATT_BUF;
        bf16x8 kf[2][4], vf[2][4];
#pragma unroll
        for (int kb = 0; kb < 2; ++kb)
#pragma unroll
            for (int s = 0; s < 4; ++s) kf[kb][s] = *(const LAS bf16x8*)(tb + kro[kb] + (((2 * s + hh) ^ ksw) << 4));
#pragma unroll
        for (int db = 0; db < 2; ++db)
#pragma unroll
            for (int ks = 0; ks < 4; ++ks) { const LAS unsigned char* vr = tb + ATT_VBUF + (db * 32 + r32) * 128;
                const v2u lo = *(const LAS v2u*)(vr + (((4 * ks + hh) ^ vsw) << 3)), hi = *(const LAS v2u*)(vr + (((4 * ks + 2 + hh) ^ vsw) << 3));
                v4u w; w.x = lo.x; w.y = lo.y; w.z = hi.x; w.w = hi.y; vf[db][ks] = __builtin_bit_cast(bf16x8, w); }
        const int tile = idx < 4 ? idx : idx + tskip;
        const bool needmask = tile >= 4 && (tile < 6 || tile >= 8);
        const int kpos0 = n * 128 - 128 + (tile - 4) * 64;
#pragma unroll
        for (int sb = 0; sb < 2; ++sb) {
            f32x16 p0, p1;
#pragma unroll
            for (int i = 0; i < 16; ++i) { p0[i] = 0.f; p1[i] = 0.f; }
#pragma unroll
            for (int s = 0; s < 4; ++s) { const bf16x8 qv = *(const LAS bf16x8*)(qlds + (sb * 4 + s) * 1024); p0 = MFMA32(kf[0][s], qv, p0); p1 = MFMA32(kf[1][s], qv, p1); }
            if (needmask) { const int qpos = q0 + sb * 32 + r32;
#pragma unroll
                for (int i = 0; i < 16; ++i) { const int dk = kpos0 + crow(i, hh) - qpos; if (dk > 128 || dk < -128) p0[i] = -1e30f; if (dk + 32 > 128 || dk + 32 < -128) p1[i] = -1e30f; } }
            float mx = fmaxf(p0[0], p1[0]);
#pragma unroll
            for (int i = 1; i < 16; ++i) mx = fmaxf(mx, fmaxf(p0[i], p1[i]));
            mx = fmaxf(mx, __shfl_xor(mx, 32));
            const float mold = mrun[sb], mnew = fmaxf(mold, mx); mrun[sb] = mnew;
            if (__any(mnew > mold)) { const float alpha = __builtin_amdgcn_exp2f(mold - mnew); lrun[sb] *= alpha;
#pragma unroll
                for (int db = 0; db < 2; ++db)
#pragma unroll
                    for (int i = 0; i < 16; ++i) o[sb][db][i] *= alpha; }
            float ps = 0.f;
#pragma unroll
            for (int i = 0; i < 16; ++i) { p0[i] = __builtin_amdgcn_exp2f(p0[i] - mnew); p1[i] = __builtin_amdgcn_exp2f(p1[i] - mnew); ps += p0[i] + p1[i]; }
            lrun[sb] += ps;
            bf16x8 pb[4]; pb[0] = pack8(p0, 0); pb[1] = pack8(p0, 1); pb[2] = pack8(p1, 0); pb[3] = pack8(p1, 1);
#pragma unroll
            for (int db = 0; db < 2; ++db)
#pragma unroll
                for (int ks = 0; ks < 4; ++ks) o[sb][db] = MFMA32(vf[db][ks], pb[ks], o[sb][db]);
        }
        if (idx + 1 < ntiles) ATT_STORE(cur ^ 1);
        __syncthreads();
    }
#undef ATT_TILE_ROW
#undef ATT_LOAD
#undef ATT_STORE
#pragma unroll
    for (int sb = 0; sb < 2; ++sb) { const float lt = lrun[sb] + __shfl_xor(lrun[sb], 32), inv = 1.0f / lt;
        bf16* dst = MIX + (size_t)(b * SEQ + q0 + sb * 32 + r32) * DM + h * HDIM;
#pragma unroll
        for (int db = 0; db < 2; ++db)
#pragma unroll
            for (int g4 = 0; g4 < 4; ++g4) { v2u w; w.x = cvtpk(o[sb][db][4 * g4] * inv, o[sb][db][4 * g4 + 1] * inv); w.y = cvtpk(o[sb][db][4 * g4 + 2] * inv, o[sb][db][4 * g4 + 3] * inv);
                *(v2u*)(dst + db * 32 + 8 * g4 + 4 * hh) = w; } }
}
__device__ __forceinline__ void unpack8(const v4u w, float (&f)[8]) { f[0] = bflo(w.x); f[1] = bfhi(w.x); f[2] = bflo(w.y); f[3] = bfhi(w.y); f[4] = bflo(w.z); f[5] = bfhi(w.z); f[6] = bflo(w.w); f[7] = bfhi(w.w); }
__device__ __forceinline__ void p3_attn_conv(Frame& F) {
    const int tid = F.wave * 64 + lane_id();
    for (int u = F.vcu; u < BATCH * NKVH * (SEQ / 128); u += F.G) attn_unit(F, u);
    const bf16* BG = (const bf16*)(F.ws + WS_BG); const bf16* CG = (const bf16*)(F.ws + WS_CG); const bf16* HV = (const bf16*)(F.ws + WS_HV); bf16* MIX = (bf16*)(F.ws + WS_MIX);
    for (int idx = F.vcu * (NWAVES * 64) + tid; idx < MTOK * (CONVW / 8); idx += F.G * NWAVES * 64) {
        const int row = idx >> 6, c8 = (idx & 63) * 8, t = row & (SEQ - 1); const size_t off = (size_t)row * CONVW + c8;
        float bgv[8], uc[8], up[8], un[8], a[8], bq[8];
        unpack8(*(const v4u*)(BG + off), bgv);
        unpack8(*(const v4u*)(CG + off), a); unpack8(*(const v4u*)(HV + off), bq);
#pragma unroll
        for (int i = 0; i < 8; ++i) uc[i] = a[i] * bq[i];
        if (t > 0) { unpack8(*(const v4u*)(CG + off - CONVW), a); unpack8(*(const v4u*)(HV + off - CONVW), bq);
#pragma unroll
            for (int i = 0; i < 8; ++i) up[i] = a[i] * bq[i]; }
        else {
#pragma unroll
            for (int i = 0; i < 8; ++i) up[i] = 0.f; }
        if (t < SEQ - 1) { unpack8(*(const v4u*)(CG + off + CONVW), a); unpack8(*(const v4u*)(HV + off + CONVW), bq);
#pragma unroll
            for (int i = 0; i < 8; ++i) un[i] = a[i] * bq[i]; }
        else {
#pragma unroll
            for (int i = 0; i < 8; ++i) un[i] = 0.f; }
        float r[8];
#pragma unroll
        for (int i = 0; i < 8; ++i) r[i] = bgv[i] * (F.conv_w[c8 + i] * up[i] + F.conv_w[CONVW + c8 + i] * uc[i] + F.conv_w[2 * CONVW + c8 + i] * un[i]);
        v4u w; w.x = cvtpk(r[0], r[1]); w.y = cvtpk(r[2], r[3]); w.z = cvtpk(r[4], r[5]); w.w = cvtpk(r[6], r[7]);
        *(v4u*)(MIX + (size_t)row * DM + ATTW + c8) = w;
    }
}

__device__ __forceinline__ void p5_norm_router(Frame& F) {
    const int lane = lane_id(), tid = F.wave * 64 + lane;
    const float* MODF = (const float*)(F.ws + WS_MODF);
    LAS float* wr = (LAS float*)(F.lds);
    LAS float* tA = wr + NEXP * DM; LAS float* tB = tA + 2 * DM;
    for (int i = tid; i < NEXP * DM; i += NWAVES * 64) { const int k = i >> 4, e = i & 15; wr[e * DM + k] = F.w_router[i]; }
    for (int i = tid; i < 2 * DM; i += NWAVES * 64) { const int b = i >> 10, k = i & (DM - 1);
        tA[i] = F.g_ffn[k] * (1.0f + MODF[(size_t)b * 6 * DM + 4 * DM + k]); tB[i] = MODF[(size_t)b * 6 * DM + 3 * DM + k]; }
    __syncthreads();
    bf16* H2 = (bf16*)(F.ws + WS_H2); float* AFF = (float*)(F.ws + WS_AFF);
    const int gw = F.vcu * NWAVES + F.wave, NGW = F.G * NWAVES;
    for (int m = gw; m < MTOK; m += NGW) {
        const int b = m >> 13, t = m & (SEQ - 1);
        const GAS f32x4* xr = (const GAS f32x4*)(F.out + (size_t)m * DM) + lane;
        f32x4 hv[4]; float ss = 0.f;
#pragma unroll
        for (int j = 0; j < 4; ++j) { hv[j] = xr[64 * j]; ss += (hv[j].x * hv[j].x + hv[j].y * hv[j].y) + (hv[j].z * hv[j].z + hv[j].w * hv[j].w); }
        const float rstd = 1.0f / sqrtf(wave_sum(ss) * (1.0f / DM) + EPS_RMS);
        GAS unsigned long long* o8 = (GAS unsigned long long*)(H2 + (size_t)m * DM) + lane;
#pragma unroll
        for (int j = 0; j < 4; ++j) { const f32x4 a = *(const LAS f32x4*)(tA + b * DM + 4 * lane + 256 * j), sh = *(const LAS f32x4*)(tB + b * DM + 4 * lane + 256 * j);
            hv[j] = hv[j] * rstd * a + sh;
            o8[64 * j] = (unsigned long long)cvtpk(hv[j].x, hv[j].y) | ((unsigned long long)cvtpk(hv[j].z, hv[j].w) << 32); }
        float r8[8];
#pragma unroll
        for (int e = 0; e < 8; ++e) { float s0 = 0.f, s1 = 0.f;
#pragma unroll
            for (int j = 0; j < 4; ++j) { const f32x4 w0 = *(const LAS f32x4*)(wr + e * DM + 4 * lane + 256 * j), w1 = *(const LAS f32x4*)(wr + (e + 8) * DM + 4 * lane + 256 * j);
                s0 += (hv[j].x * w0.x + hv[j].y * w0.y) + (hv[j].z * w0.z + hv[j].w * w0.w); s1 += (hv[j].x * w1.x + hv[j].y * w1.y) + (hv[j].z * w1.z + hv[j].w * w1.w); }
            const bool up = (lane & 32) != 0; r8[e] = (up ? s1 : s0) + __shfl_xor(up ? s0 : s1, 32);
            asm volatile("" ::: "memory"); }
        float r4[4], r2[2];
#pragma unroll
        for (int e = 0; e < 4; ++e) { const bool up = (lane & 16) != 0; r4[e] = (up ? r8[e + 4] : r8[e]) + __shfl_xor(up ? r8[e] : r8[e + 4], 16); }
#pragma unroll
        for (int e = 0; e < 2; ++e) { const bool up = (lane & 8) != 0; r2[e] = (up ? r4[e + 2] : r4[e]) + __shfl_xor(up ? r4[e] : r4[e + 2], 8); }
        float lg; { const bool up = (lane & 4) != 0; lg = (up ? r2[1] : r2[0]) + __shfl_xor(up ? r2[0] : r2[1], 4); }
        lg += __shfl_xor(lg, 2); lg += __shfl_xor(lg, 1);
        float mx = lg;
#pragma unroll
        for (int o = 4; o < 64; o <<= 1) mx = fmaxf(mx, __shfl_xor(mx, o));
        const float ex = __expf(lg - mx); float den = ex;
#pragma unroll
        for (int o = 4; o < 64; o <<= 1) den += __shfl_xor(den, o);
        const float mine = ex / den; const int myexp = ((lane >> 5) & 1) * 8 + ((lane >> 4) & 1) * 4 + ((lane >> 3) & 1) * 2 + ((lane >> 2) & 1);
        if ((lane & 3) == 0) AFF[(size_t)(b * NEXP + myexp) * SEQ + t] = mine;
    }
}

__device__ __forceinline__ int block_excl_scan(int v, LAS int* wsum, int lane, int wave, int& total) {
    int x = v;
#pragma unroll
    for (int o = 1; o < 64; o <<= 1) { const int y = __shfl_up(x, o); if (lane >= o) x += y; }
    if (lane == 63) wsum[wave] = x;
    __syncthreads();
    int base = 0, tot = 0;
#pragma unroll
    for (int w = 0; w < NWAVES; ++w) { const int s = wsum[w]; base += (w < wave) ? s : 0; tot += s; }
    __syncthreads();
    total = tot; return base + x - v;
}
__device__ __forceinline__ void p6_topk_task(Frame& F, int task) {
    const int b = task >> 7, e = (task >> 3) & 15, part = task & 7, lane = lane_id(), tid = F.wave * 64 + lane;
    LAS unsigned* keys = (LAS unsigned*)(F.lds);
    LAS unsigned* hist = (LAS unsigned*)(F.lds + 32768);
    LAS int* misc = (LAS int*)(F.lds + 32768 + 1024);
    LAS int* list = (LAS int*)(F.lds + 36864);
    const float* aff = (const float*)(F.ws + WS_AFF) + (size_t)(b * NEXP + e) * SEQ;
    __syncthreads();
    for (int i = tid; i < SEQ / 4; i += NWAVES * 64) *(LAS v4u*)(keys + 4 * i) = *(const v4u*)(aff + 4 * i);
    __syncthreads();
    unsigned prefix = 0u, mask = 0u; int kk = CAP;
    for (int pass = 3; pass >= 0; --pass) {
        if (tid < 256) hist[tid] = 0u;
        __syncthreads();
        const int sh = pass * 8;
#pragma unroll 4
        for (int j = 0; j < 16; ++j) { const unsigned k = keys[tid + 512 * j]; if ((k & mask) == prefix) __hip_atomic_fetch_add(hist + ((k >> sh) & 255u), 1u, __ATOMIC_RELAXED, __HIP_MEMORY_SCOPE_WORKGROUP); }
        __syncthreads();
        if (F.wave == 0) {
            const int c0 = (int)hist[255 - 4 * lane], c1 = (int)hist[254 - 4 * lane], c2 = (int)hist[253 - 4 * lane], c3 = (int)hist[252 - 4 * lane];
            const int s = c0 + c1 + c2 + c3; int incl = s;
#pragma unroll
            for (int o = 1; o < 64; o <<= 1) { const int y = __shfl_up(incl, o); if (lane >= o) incl += y; }
            const int excl = incl - s;
            if (excl < kk && incl >= kk) { const int r = kk - excl; int bin, above;
                if (r <= c0) { bin = 255 - 4 * lane; above = 0; } else if (r <= c0 + c1) { bin = 254 - 4 * lane; above = c0; }
                else if (r <= c0 + c1 + c2) { bin = 253 - 4 * lane; above = c0 + c1; } else { bin = 252 - 4 * lane; above = c0 + c1 + c2; }
                misc[0] = bin; misc[1] = r - above; }
        }
        __syncthreads();
        prefix |= (unsigned)misc[0] << sh; mask |= 255u << sh; kk = misc[1];
        __syncthreads();
    }
    const unsigned thr = prefix; const int need = kk;
    const int t0 = part * (SEQ / 8);
    int cgt = 0, ceq = 0;
#pragma unroll 4
    for (int j = 0; j < 16; ++j) { const int i = tid + 512 * j; const unsigned k = keys[i]; if (i < t0) { cgt += (k > thr) ? 1 : 0; ceq += (k == thr) ? 1 : 0; } }
    int gt_before, eq_before;
    (void)block_excl_scan(cgt, misc + 16, lane, F.wave, gt_before);
    (void)block_excl_scan(ceq, misc + 16, lane, F.wave, eq_before);
    const int tA = t0 + 2 * tid; const unsigned kA = keys[tA], kB = keys[tA + 1];
    const int eqA = (kA == thr) ? 1 : 0, eqB = (kB == thr) ? 1 : 0; int dummy;
    const int eqx = block_excl_scan(eqA + eqB, misc + 16, lane, F.wave, dummy);
    const int eposA = eq_before + eqx, eposB = eposA + eqA;
    const int selA = (kA > thr || (eqA && eposA < need)) ? 1 : 0, selB = (kB > thr || (eqB && eposB < need)) ? 1 : 0;
    int nloc;
    const int sx = block_excl_scan(selA + selB, misc + 16, lane, F.wave, nloc);
    const int sel_before = gt_before + (eq_before < need ? eq_before : need);
    int* SEL = (int*)(F.ws + WS_SEL); float* GSEL = (float*)(F.ws + WS_GSEL);
    const int slotA = sel_before + sx, slotB = slotA + selA; const size_t eb = (size_t)(e * 2 + b) * CAP;
    SEL[(size_t)(b * SEQ + tA) * NEXP + e] = selA ? slotA : -1; SEL[(size_t)(b * SEQ + tA + 1) * NEXP + e] = selB ? slotB : -1;
    if (selA) { GSEL[eb + slotA] = __uint_as_float(kA); list[sx] = tA; }
    if (selB) { GSEL[eb + slotB] = __uint_as_float(kB); list[sx + selA] = tA + 1; }
    __syncthreads();
    const bf16* H2 = (const bf16*)(F.ws + WS_H2); bf16* XS = (bf16*)(F.ws + WS_XS);
    for (int r = F.wave; r < nloc; r += NWAVES) { const int tok = list[r];
        const v4u* src = (const v4u*)(H2 + (size_t)(b * SEQ + tok) * DM); v4u* dst = (v4u*)(XS + (eb + sel_before + r) * DM);
        const v4u a = src[lane], c = src[lane + 64]; dst[lane] = a; dst[lane + 64] = c; }
}

__device__ __forceinline__ void p9_final(Frame& F, float* dst_base) {
    const int lane = lane_id();
    const float* MODF = (const float*)(F.ws + WS_MODF); const int* SEL = (const int*)(F.ws + WS_SEL); const bf16* Y = (const bf16*)(F.ws + WS_Y);
    const int gw = F.vcu * NWAVES + F.wave, NGW = F.G * NWAVES;
    for (int m = gw; m < MTOK; m += NGW) {
        const int b = m >> 13;
        GAS f32x4* xr = (GAS f32x4*)(F.out + (size_t)m * DM) + lane;
        f32x4 xv[4], acc[4];
#pragma unroll
        for (int j = 0; j < 4; ++j) { xv[j] = xr[64 * j]; acc[j] = (f32x4){0.f, 0.f, 0.f, 0.f}; }
        const int selv = (lane < NEXP) ? SEL[(size_t)m * NEXP + lane] : -1;
#pragma unroll
        for (int e = 0; e < NEXP; ++e) { const int s = __builtin_amdgcn_readlane(selv, e);
            if (s >= 0) { const GAS v2u* yr = (const GAS v2u*)(Y + ((size_t)(e * 2 + b) * CAP + s) * DM) + lane;
#pragma unroll
                for (int j = 0; j < 4; ++j) { const v2u w = yr[64 * j]; acc[j].x += bflo(w.x); acc[j].y += bfhi(w.x); acc[j].z += bflo(w.y); acc[j].w += bfhi(w.y); } } }
        float ss = 0.f;
#pragma unroll
        for (int j = 0; j < 4; ++j) { const f32x4 gt = *(const f32x4*)(MODF + (size_t)b * 6 * DM + 5 * DM + 4 * lane + 256 * j);
            xv[j] = xv[j] + gt * acc[j]; ss += (xv[j].x * xv[j].x + xv[j].y * xv[j].y) + (xv[j].z * xv[j].z + xv[j].w * xv[j].w); }
        const float rstd = 1.0f / sqrtf(wave_sum(ss) * (1.0f / DM) + EPS_RMS);
#pragma unroll
        for (int j = 0; j < 4; ++j) { const f32x4 gf = *(const f32x4*)(F.g_final + 4 * lane + 256 * j); ((GAS f32x4*)(dst_base + (size_t)m * DM) + lane)[64 * j] = xv[j] * rstd * gf; }
    }
}

struct Args { const float* in[17]; float* out; unsigned char* ws; int ph_lo, ph_hi; };
__global__ void __launch_bounds__(NWAVES * 64, 2) dit_fwd(Args args) {
    extern __shared__ __attribute__((aligned(16))) unsigned char lds[];
    Frame F;
    F.lds = (LAS unsigned char*)lds;
    F.MISC = (volatile LAS unsigned*)(F.lds + MISC_OFF);
    F.wave = __builtin_amdgcn_readfirstlane((int)threadIdx.x >> 6);
    F.G = gridDim.x; { const int bx = blockIdx.x; F.vcu = (F.G % 8 == 0) ? (bx % 8) * (F.G / 8) + bx / 8 : bx; }
    F.ws = args.ws; F.out = args.out; F.ctl = (gu32*)(args.ws + WS_CTL);
    F.x = args.in[0]; F.c = args.in[1]; F.ctx = args.in[2]; F.c_ctx = args.in[3]; F.w_ada = args.in[4]; F.b_ada = args.in[5]; F.g_mix = args.in[6]; F.w_in = args.in[7];
    F.conv_w = args.in[8]; F.sink = args.in[9]; F.w_out = args.in[10]; F.g_ffn = args.in[11]; F.w_router = args.in[12]; F.w_gate = args.in[13]; F.w_up = args.in[14];
    F.w_down = args.in[15]; F.g_final = args.in[16];
    for (int u = ftid(F); u < (LDS_BYTES - LDSCTL_OFF) / 4; u += NWAVES * 64) ((LAS unsigned*)(F.lds + LDSCTL_OFF))[u] = 0u;
    __syncthreads();
    XcdBarrier bar; bar.bar = (unsigned*)(F.ctl + CW_BAR); bar.x = 0; bar.st = nullptr; bar.w = F.wave;
    if (N_LAUNCHES == 1) bar = xcd_barrier_post((unsigned*)(F.ctl + CW_BAR), F.MISC + 8, F.wave);
    const int lo = args.ph_lo, hi = args.ph_hi;
#ifdef DBG_ONLY
#define IN(k) ((k) == DBG_ONLY && lo <= (k) && (k) < hi)
#else
#define IN(k) (lo <= (k) && (k) < hi)
#endif
#define SEAM(k) do { if (IN(k) && IN((k) + 1)) xcd_barrier(bar); } while (0)
#ifdef DBG_DUP
#define REP(k) for (int rep_ = 0; rep_ < ((k) == DBG_DUP ? 2 : 1); ++rep_)
#define REPBAR(k) do { if ((k) == DBG_DUP && rep_ == 0 && N_LAUNCHES == 1) xcd_barrier(bar); } while (0)
#else
#define REP(k)
#define REPBAR(k) do { } while (0)
#endif

    if (IN(0)) { REP(0) { p0_prologue(F); REPBAR(0); } SEAM(0); }
    if (IN(1)) { REP(1) { p1_norm(F); REPBAR(1); } SEAM(1); }
    if (IN(2)) {
        pg8::Gemm g{(const pg8::bf16_t*)(F.ws + WS_XN), (const pg8::bf16_t*)(F.ws + WS_WIN), MALL, INW, DM};
        pg8::InProjOrder S{F.G, (int)blockIdx.x};
        const float* cosT = (const float*)(F.ws + WS_ROPE);
        pg8::EpiInProj E{(pg8::bf16_t*)(F.ws + WS_Q), (pg8::bf16_t*)(F.ws + WS_K), (pg8::bf16_t*)(F.ws + WS_VT), (pg8::bf16_t*)(F.ws + WS_BG), cosT, cosT + 128 * 16};
        static_assert(WS_CG == WS_BG + (size_t)MTOK * CONVW * 2 && WS_HV == WS_CG + (size_t)MTOK * CONVW * 2, "bg | cg | hv contiguous");
        REP(2) { pg8::gemm_phase<pg8::EpiInProj, pg8::InProjOrder, PG8_ALIGN, PG8_SP2>(F.lds + RING_OFF, g, S, E, F.wave); REPBAR(2); }
        SEAM(2);
    }
    if (IN(3)) { REP(3) { p3_attn_conv(F); REPBAR(3); } SEAM(3); }
    if (IN(4)) {
        pg8::Gemm g{(const pg8::bf16_t*)(F.ws + WS_MIX), (const pg8::bf16_t*)(F.ws + WS_WO), MTOK, DM, DM};
        pg8::StaticOrder S; S.init(MTOK, DM, F.G, (int)blockIdx.x);
        pg8::EpiOutProj E{F.x, F.out, (const float*)(F.ws + WS_MODF)};
        REP(4) { pg8::gemm_phase<pg8::EpiOutProj, pg8::StaticOrder, PG8_ALIGN, PG8_SP2>(F.lds + RING_OFF, g, S, E, F.wave); REPBAR(4); }
        SEAM(4);
    }
    if (IN(5)) { REP(5) { p5_norm_router(F); REPBAR(5); } SEAM(5); }
    if (IN(6)) { REP(6) { for (int task = F.vcu; task < BATCH * NEXP * 8; task += F.G) p6_topk_task(F, task); REPBAR(6); } SEAM(6); }
    if (IN(7)) {
        pg8::Gemm g{(const pg8::bf16_t*)(F.ws + WS_XS), (const pg8::bf16_t*)(F.ws + WS_WGU), NEXP * 2 * CAP, NEXP * 2 * DEXP, DM};
        pg8::MoeOrder<8> S{F.G, (int)blockIdx.x};
        pg8::EpiGateUp E{(pg8::bf16_t*)(F.ws + WS_ACT)};
        REP(7) { pg8::gemm_phase<pg8::EpiGateUp, pg8::MoeOrder<8>, PG8_ALIGN, PG8_SP2>(F.lds + RING_OFF, g, S, E, F.wave); REPBAR(7); }
        SEAM(7);
    }
    if (IN(8)) {
        pg8::Gemm g{(const pg8::bf16_t*)(F.ws + WS_ACT), (const pg8::bf16_t*)(F.ws + WS_WD), NEXP * 2 * CAP, NEXP * DM, DEXP};
        pg8::MoeOrder<4> S{F.G, (int)blockIdx.x};
        pg8::EpiDown E{(pg8::bf16_t*)(F.ws + WS_Y), (const float*)(F.ws + WS_GSEL)};
        REP(8) { pg8::gemm_phase<pg8::EpiDown, pg8::MoeOrder<4>, PG8_ALIGN, PG8_SP2>(F.lds + RING_OFF, g, S, E, F.wave); REPBAR(8); }
        SEAM(8);
    }
#if defined(DBG_DUP) && DBG_DUP == 9
    if (IN(9)) { p9_final(F, (float*)(F.ws + WS_WGU)); xcd_barrier(bar); p9_final(F, F.out); }
#elif defined(DBG_DUP) && DBG_DUP == 10
    if (IN(9)) { for (int i = 0; i < 8; ++i) xcd_barrier(bar); p9_final(F, F.out); }
#else
    if (IN(9)) { p9_final(F, F.out); }
#endif
#undef IN
#undef SEAM
}

extern "C" void kernel_launch(void* const* d_in, const int* in_sizes, int n_in, void* d_out, int out_size, void* d_ws, size_t ws_size, hipStream_t stream) {
    static int grid = 0;
    if (grid == 0) {
        if (n_in != 17 || in_sizes[0] != MTOK * DM || out_size != MTOK * DM || ws_size < WS_END) { fprintf(stderr, "kernel_launch: unexpected shapes (n_in %d, in0 %d, out %d, ws %zu); nothing launched\n", n_in, n_in > 0 ? in_sizes[0] : -1, out_size, ws_size); grid = -1; return; }
        int dev = 0, cus = 0, per_cu = 0;
        if (hipGetDevice(&dev) != hipSuccess || hipDeviceGetAttribute(&cus, hipDeviceAttributeMultiprocessorCount, dev) != hipSuccess) { fprintf(stderr, "kernel_launch: device query failed\n"); grid = -1; return; }
        if (hipFuncSetAttribute((const void*)dit_fwd, hipFuncAttributeMaxDynamicSharedMemorySize, LDS_BYTES) != hipSuccess) { fprintf(stderr, "kernel_launch: hipFuncSetAttribute failed\n"); grid = -1; return; }
        if (hipOccupancyMaxActiveBlocksPerMultiprocessor(&per_cu, (const void*)dit_fwd, NWAVES * 64, LDS_BYTES) != hipSuccess || per_cu < 1) { fprintf(stderr, "kernel_launch: occupancy query reports %d workgroups per CU\n", per_cu); per_cu = 1; }
        (void)hipGetLastError();
        grid = cus;
    }
    if (grid < 0) return;
    (void)hipMemsetAsync((char*)d_ws + WS_CTL, 0, CTL_ZERO_BYTES, stream);
    Args a{};
    for (int i = 0; i < 17; ++i) a.in[i] = (const float*)d_in[i];
    a.out = (float*)d_out; a.ws = (unsigned char*)d_ws;
    if (N_LAUNCHES == 1) { a.ph_lo = 0; a.ph_hi = NPH; hipLaunchKernelGGL(dit_fwd, dim3(grid), dim3(NWAVES * 64), LDS_BYTES, stream, a); }
    else for (int li = 0; li < NPH; ++li) { a.ph_lo = li; a.ph_hi = li + 1; hipLaunchKernelGGL(dit_fwd, dim3(grid), dim3(NWAVES * 64), LDS_BYTES, stream, a); }
}
```

```cpp
#include <hip/hip_runtime.h>
#include <cstdio>
#include <cstdint>
namespace pg8 {
#define PG8_LAS __attribute__((address_space(3)))
typedef unsigned short bf16_t;
typedef short bf16x8 __attribute__((ext_vector_type(8)));
typedef float f32x4 __attribute__((ext_vector_type(4)));
typedef unsigned u32x4 __attribute__((ext_vector_type(4)));
constexpr int BM = 256, BK = 64, HALF = 128, HTB = HALF * BK * 2  , STAGE_BYTES = 8 * HTB, NXCD = 8, WGM = 8;

__host__ __device__ __forceinline__ int lds_byte(int r, int c) { const int st = (r >> 4) * 2 + (c >> 5), rr = r & 15, cc = c & 31, ob = rr * 64 + cc * 2; return st * 1024 + (ob ^ (((ob >> 9) & 1) << 5)); }
__host__ __device__ __forceinline__ void stage_rc(int b, int& R, int& C) { const int st = b / 1024, sb = b % 1024, swz = sb ^ (((sb >> 9) & 1) << 5); R = (st >> 1) * 16 + swz / 64; C = (st & 1) * 32 + (swz % 64) / 2; }
__host__ __device__ __forceinline__ int perm32(int rho) { const int n = rho >> 4, i = rho & 15; return 8 * (i >> 2) + 4 * n + (i & 3); }

struct Unit { int pm, pn; };
struct Gemm { const bf16_t* A; const bf16_t* Bt; int M, N, K; };

struct StaticOrder {
    int nM, nN, nwg, G, c;
    __host__ __device__ void init(int M, int N, int G_, int c_) { nM = M / BM; nN = N / BM; nwg = nM * nN; G = G_; c = c_; }
    __host__ __device__ bool next(int i, Unit& u) const {
        const long L = (long)i * G + c; if (L >= nwg) return false;
        int wgid = (int)L; { const int q = nwg / NXCD, r = nwg % NXCD, xcd = wgid % NXCD, off = wgid / NXCD; wgid = (xcd < r ? xcd * (q + 1) : r * (q + 1) + (xcd - r) * q) + off; }
        const int nig = WGM * nN, gid = wgid / nig, fm = gid * WGM, gsz = (nM - fm) < WGM ? (nM - fm) : WGM;
        u.pm = fm + ((wgid % nig) % gsz); u.pn = (wgid % nig) / gsz; return true;
    }
    __device__ __forceinline__ void a_ready(const Unit&) const {}
    __device__ __forceinline__ void done(const Unit&) const {}
};

__device__ __forceinline__ unsigned cvt_pk_bf16(float lo, float hi) { unsigned r; asm volatile("v_cvt_pk_bf16_f32 %0, %1, %2" : "=v"(r) : "v"(lo), "v"(hi)); return r; }
__device__ __forceinline__ int pg8_lane() { int l; asm volatile("v_mbcnt_lo_u32_b32 %0, -1, 0\n\tv_mbcnt_hi_u32_b32 %0, -1, %0" : "=v"(l)); return l; }
template <class Epi, class Sched, bool ALIGN_EPI = false, bool SP2 = false, bool GATHER = false>
__device__ __forceinline__ void gemm_phase(PG8_LAS unsigned char* lds, const Gemm g, const Sched& S, const Epi& E, const int wave_id) {
    const int wid = wave_id, lane = pg8_lane(), tid = wid * 64 + lane, wr = wid >> 2, wc = wid & 3, fr = lane & 15, fq = lane >> 4;
    const int K = g.K, nt = K / BK;
    unsigned voffA[2], voffB[2];
#pragma unroll
    for (int i = 0; i < 2; ++i) { int R, C; stage_rc(tid * 16 + i * 8192, R, C); const int Rb = Epi::PERM ? ((R & ~31) + perm32(R & 31)) : R;
        voffA[i] = (unsigned)(R * K + C) * 2u; voffB[i] = (unsigned)(Rb * K + C) * 2u; }
    static_assert(!GATHER || SP2, "GATHER is implemented for the SP2 loop");
    int gR[2]; unsigned gC[2]; unsigned va[2][2], vn[2][2];
#pragma unroll
    for (int i = 0; i < 2; ++i) { int R, C; stage_rc(tid * 16 + i * 8192, R, C); gR[i] = R; gC[i] = (unsigned)C * 2u; va[0][i] = va[1][i] = vn[0][i] = vn[1][i] = 0u; }
#define PG8_GROWS(dst, pm_) do { if constexpr (GATHER) { _Pragma("unroll") for (int h_ = 0; h_ < 2; ++h_) _Pragma("unroll") for (int i_ = 0; i_ < 2; ++i_) \
        dst[h_][i_] = (unsigned)S.rowidx[(pm_) * BM + h_ * HALF + gR[i_]] * (unsigned)(K * 2) + gC[i_]; } } while (0)
#define PG8_STAGE_A(bufoff, gbase, H, NX) do { if constexpr (GATHER) { _Pragma("unroll") for (int _i = 0; _i < 2; ++_i) \
        __builtin_amdgcn_global_load_lds((const unsigned*)((const char*)(gbase) + ((NX) ? vn[H][_i] : va[H][_i])), (PG8_LAS unsigned*)(lds + (bufoff) + ldsw + _i * 8192), 16, 0, 0); } \
    else { PG8_STAGE(bufoff, (gbase) + (H) * hstep, voffA); } } while (0)
    const size_t kstep = (size_t)(BK * 2);
    const size_t hstep = (size_t)HALF * K * 2;
    const size_t tstep = 2 * hstep;
    const unsigned ldsw = (unsigned)wid * 1024u;
    const int aoff = lds_byte(wr * 64 + fr, fq * 8), boff = lds_byte(wc * 32 + fr, fq * 8);
#define PG8_SA(b, h) (((b) * 2 + (h)) * HTB)
#define PG8_SB(b, h) ((4 + (b) * 2 + (h)) * HTB)
#define PG8_STAGE(bufoff, gbase, voff) do { _Pragma("unroll") for (int _i = 0; _i < 2; ++_i) \
        __builtin_amdgcn_global_load_lds((const unsigned*)((const char*)(gbase) + (voff)[_i]), (PG8_LAS unsigned*)(lds + (bufoff) + ldsw + _i * 8192), 16, 0, 0); } while (0)
#define PG8_LDA(dst, b, h) do { _Pragma("unroll") for (int m = 0; m < 4; ++m) _Pragma("unroll") for (int k = 0; k < 2; ++k) dst[m][k] = *(const PG8_LAS bf16x8*)(lds + PG8_SA(b, h) + aoff + m * 2048 + k * 1024); } while (0)
#define PG8_LDB(dst, b, h) do { _Pragma("unroll") for (int n = 0; n < 2; ++n) _Pragma("unroll") for (int k = 0; k < 2; ++k) dst[n][k] = *(const PG8_LAS bf16x8*)(lds + PG8_SB(b, h) + boff + n * 2048 + k * 1024); } while (0)
#define PG8_MMA(ai, bj, At, Bt) do { __builtin_amdgcn_s_setprio(1); _Pragma("unroll") for (int m = 0; m < 4; ++m) _Pragma("unroll") for (int n = 0; n < 2; ++n) _Pragma("unroll") for (int k = 0; k < 2; ++k) \
        acc[ai][bj][m][n] = __builtin_amdgcn_mfma_f32_16x16x32_bf16(Bt[n][k], At[m][k], acc[ai][bj][m][n], 0, 0, 0); __builtin_amdgcn_s_setprio(0); } while (0)
#define PG8_WAIT_V(n) asm volatile("s_waitcnt vmcnt(" #n ")" ::: "memory")
#define PG8_WAIT_L(n) asm volatile("s_waitcnt lgkmcnt(" #n ")" ::: "memory")
#define PG8_BAR __builtin_amdgcn_s_barrier()
#define PG8_SCHED __builtin_amdgcn_sched_barrier(0)
    Unit cur, nxt; int ui = 0;
    if (!S.next(0, cur)) return;
    f32x4 acc[2][2][4][2];
#pragma unroll
    for (int a = 0; a < 2; ++a)
#pragma unroll
        for (int b = 0; b < 2; ++b)
#pragma unroll
            for (int m = 0; m < 4; ++m)
#pragma unroll
                for (int n = 0; n < 2; ++n) acc[a][b][m][n] = (f32x4){0.f, 0.f, 0.f, 0.f};
    bf16x8 At[4][2], B0[2][2], B1[2][2];
    const char* cA = (const char*)g.A + (GATHER ? (size_t)0 : (size_t)cur.pm * tstep); PG8_GROWS(va, cur.pm); const char* cB = (const char*)g.Bt + (size_t)cur.pn * tstep;
    S.a_ready(cur);
    if constexpr (SP2) {
        PG8_STAGE(PG8_SB(0, 0), cB, voffB); PG8_STAGE(PG8_SB(0, 1), cB + hstep, voffB); PG8_STAGE_A(PG8_SA(0, 0), cA, 0, false); PG8_STAGE_A(PG8_SA(0, 1), cA, 1, false);
        if (wr == 1) PG8_BAR;
        PG8_WAIT_V(2); PG8_BAR;
        PG8_STAGE(PG8_SB(1, 0), cB + kstep, voffB); PG8_STAGE_A(PG8_SA(1, 0), cA + kstep, 0, false); PG8_STAGE(PG8_SB(1, 1), cB + hstep + kstep, voffB);
        PG8_WAIT_V(6); PG8_BAR;
    } else {
        PG8_STAGE(PG8_SB(0, 0), cB, voffB); PG8_STAGE(PG8_SA(0, 0), cA, voffA); PG8_STAGE(PG8_SB(0, 1), cB + hstep, voffB); PG8_STAGE(PG8_SA(0, 1), cA + hstep, voffA);
        if (wr == 1) PG8_BAR;
        PG8_WAIT_V(4); PG8_BAR;
        PG8_STAGE(PG8_SB(1, 0), cB + kstep, voffB); PG8_STAGE(PG8_SA(1, 0), cA + kstep, voffA); PG8_STAGE(PG8_SB(1, 1), cB + hstep + kstep, voffB);
        PG8_WAIT_V(6); PG8_BAR;
    }
    for (;;) {
        const bool has_next = S.next(ui + 1, nxt);
        const char* nA = (has_next && !GATHER) ? (const char*)g.A + (size_t)nxt.pm * tstep : cA;
        if constexpr (GATHER) { if (has_next) { PG8_GROWS(vn, nxt.pm); } else { _Pragma("unroll") for (int h_ = 0; h_ < 2; ++h_) _Pragma("unroll") for (int i_ = 0; i_ < 2; ++i_) vn[h_][i_] = va[h_][i_]; } } const char* nB = has_next ? (const char*)g.Bt + (size_t)nxt.pn * tstep : cB;
        for (int t = 0; t < nt; t += 2) {
            const bool last = (t == nt - 2);
            const char* a1 = cA + (size_t)(t + 1) * kstep;
            const char* a2 = last ? nA : cA + (size_t)(t + 2) * kstep; const char* b2 = last ? nB : cB + (size_t)(t + 2) * kstep;
            const char* a3 = a2 + kstep; const char* b3 = b2 + kstep;
            if (last && has_next) S.a_ready(nxt);
            if constexpr (SP2) {
            PG8_LDB(B0, 0, 0); PG8_LDB(B1, 0, 1); PG8_SCHED; PG8_LDA(At, 0, 0); PG8_STAGE_A(PG8_SA(1, 1), a1, 1, false);
            PG8_WAIT_V(8); PG8_WAIT_L(0); PG8_BAR; PG8_MMA(0, 0, At, B0); PG8_MMA(0, 1, At, B1); PG8_BAR; PG8_SCHED;
            PG8_LDA(At, 0, 1); PG8_STAGE(PG8_SB(0, 0), b2, voffB); PG8_STAGE(PG8_SB(0, 1), b2 + hstep, voffB); PG8_STAGE_A(PG8_SA(0, 0), a2, 0, last);
            PG8_WAIT_V(8); PG8_WAIT_L(0); PG8_BAR; PG8_MMA(1, 0, At, B0); PG8_MMA(1, 1, At, B1); PG8_BAR; PG8_SCHED;
            PG8_LDB(B0, 1, 0); PG8_LDB(B1, 1, 1); PG8_SCHED; PG8_LDA(At, 1, 0); PG8_STAGE_A(PG8_SA(0, 1), a2, 1, last);
            PG8_WAIT_V(8); PG8_WAIT_L(0); PG8_BAR; PG8_MMA(0, 0, At, B0); PG8_MMA(0, 1, At, B1); PG8_BAR; PG8_SCHED;
            PG8_LDA(At, 1, 1); PG8_STAGE(PG8_SB(1, 0), b3, voffB); PG8_STAGE(PG8_SB(1, 1), b3 + hstep, voffB); PG8_STAGE_A(PG8_SA(1, 0), a3, 0, last);
            PG8_WAIT_V(8); PG8_WAIT_L(0); PG8_BAR; PG8_MMA(1, 0, At, B0); PG8_MMA(1, 1, At, B1); PG8_BAR; PG8_SCHED;
            } else {
            PG8_LDB(B0, 0, 0); PG8_SCHED; PG8_LDA(At, 0, 0); PG8_STAGE(PG8_SA(1, 1), a1 + hstep, voffA);
            PG8_WAIT_L(8); PG8_BAR; PG8_WAIT_L(0); PG8_MMA(0, 0, At, B0); PG8_BAR; PG8_SCHED;
            PG8_LDB(B1, 0, 1); PG8_STAGE(PG8_SB(0, 0), b2, voffB);
            PG8_BAR; PG8_WAIT_L(0); PG8_MMA(0, 1, At, B1); PG8_BAR;
            PG8_LDA(At, 0, 1); PG8_STAGE(PG8_SA(0, 0), a2, voffA);
            PG8_BAR; PG8_WAIT_L(0); PG8_MMA(1, 0, At, B0); PG8_BAR; PG8_SCHED;
            PG8_STAGE(PG8_SB(0, 1), b2 + hstep, voffB);
            PG8_WAIT_V(6); PG8_BAR; PG8_MMA(1, 1, At, B1); PG8_BAR;
            PG8_LDB(B0, 1, 0); PG8_SCHED; PG8_LDA(At, 1, 0); PG8_STAGE(PG8_SA(0, 1), a2 + hstep, voffA);
            PG8_WAIT_L(8); PG8_BAR; PG8_WAIT_L(0); PG8_MMA(0, 0, At, B0); PG8_BAR; PG8_SCHED;
            PG8_LDB(B1, 1, 1); PG8_STAGE(PG8_SB(1, 0), b3, voffB);
            PG8_BAR; PG8_WAIT_L(0); PG8_MMA(0, 1, At, B1); PG8_BAR;
            PG8_LDA(At, 1, 1); PG8_STAGE(PG8_SA(1, 0), a3, voffA);
            PG8_BAR; PG8_WAIT_L(0); PG8_MMA(1, 0, At, B0); PG8_BAR; PG8_SCHED;
            PG8_STAGE(PG8_SB(1, 1), b3 + hstep, voffB);
            PG8_WAIT_V(6); PG8_BAR; PG8_MMA(1, 1, At, B1); PG8_BAR;
            }
        }
        if constexpr (ALIGN_EPI) { if (wr == 0) PG8_BAR; }
        if constexpr (!Epi::AFTER_DRAIN) { E(acc, cur, wr, wc, fr, fq); S.done(cur); }
        if (!has_next) break;
#pragma unroll
        for (int a = 0; a < 2; ++a)
#pragma unroll
            for (int b = 0; b < 2; ++b)
#pragma unroll
                for (int m = 0; m < 4; ++m)
#pragma unroll
                    for (int n = 0; n < 2; ++n) acc[a][b][m][n] = (f32x4){0.f, 0.f, 0.f, 0.f};
        cur = nxt; cA = nA; cB = nB; ++ui;
        if constexpr (GATHER) { _Pragma("unroll") for (int h_ = 0; h_ < 2; ++h_) _Pragma("unroll") for (int i_ = 0; i_ < 2; ++i_) va[h_][i_] = vn[h_][i_]; }
        if constexpr (ALIGN_EPI) { if (wr == 1) PG8_BAR; }
    }
    PG8_WAIT_V(0);
    if constexpr (!ALIGN_EPI) { if (wr == 0) PG8_BAR; }
    PG8_BAR;
    if constexpr (Epi::AFTER_DRAIN) { E.fused(acc, cur, wr, wc, fr, fq, lds, wid, lane); S.done(cur); }
#undef PG8_SA
#undef PG8_SB
#undef PG8_STAGE
#undef PG8_STAGE_A
#undef PG8_GROWS
#undef PG8_LDA
#undef PG8_LDB
#undef PG8_MMA
#undef PG8_WAIT_V
#undef PG8_WAIT_L
#undef PG8_BAR
#undef PG8_SCHED
}
}

constexpr int BATCH = 2, SEQ = 8192, DM = 1024, MTOK = BATCH * SEQ, CTXL = 256, MCTX = BATCH * CTXL, MALL = MTOK + MCTX;
constexpr int NHEAD = 8, NKVH = 2, HDIM = 64, ATTW = 512, KVW = 128, CONVW = 512, INW = 2304;
constexpr int NEXP = 16, CAP = 1024, DEXP = 1024;
constexpr int KVROWS = CTXL + SEQ;
constexpr float EPS_RMS = 1e-6f;
constexpr float QSCALE = 0.125f * 1.4426950408889634f;

namespace pg8 {
typedef unsigned u32x2 __attribute__((ext_vector_type(2)));
__device__ __forceinline__ float bf2f(unsigned short h) { return __uint_as_float((unsigned)h << 16); }

struct InProjOrder {
    int G, c;
    __device__ bool next(int i, Unit& u) const {
        const int L = i * G + c; constexpr int nM = 64, nN = 9, nwg = nM * nN;
        if (L >= nwg + 2) return false;
        if (L >= nwg) { u.pm = 64 + (L - nwg); u.pn = 2; return true; }
        int wgid = L; { const int q = nwg / NXCD, r = nwg % NXCD, xcd = wgid % NXCD, off = wgid / NXCD; wgid = (xcd < r ? xcd * (q + 1) : r * (q + 1) + (xcd - r) * q) + off; }
        const int nig = WGM * nN, gid = wgid / nig, fm = gid * WGM, gsz = (nM - fm) < WGM ? (nM - fm) : WGM;
        u.pm = fm + ((wgid % nig) % gsz); u.pn = (wgid % nig) / gsz; return true;
    }
    __device__ __forceinline__ void a_ready(const Unit&) const {}
    __device__ __forceinline__ void done(const Unit&) const {}
};
template <int NPE> struct MoeOrder {
    int G, c; const int* rowidx;
    __device__ bool next(int i, Unit& u) const {
        const int L = i * G + c; constexpr int U = NEXP * 8 * NPE;
        if (L >= U) return false;
        const int id = (L % NXCD) * (U / NXCD) + L / NXCD;
        const int e = id / (8 * NPE), sub = id % (8 * NPE);
        u.pm = e * 8 + (sub & 7); u.pn = e * NPE + (sub >> 3); return true;
    }
    __device__ __forceinline__ void a_ready(const Unit&) const {}
    __device__ __forceinline__ void done(const Unit&) const {}
};

struct EpiInProj {
    static constexpr bool PERM = true, AFTER_DRAIN = false;
    bf16_t *Q, *Kb, *Vt, *BG; const float* cosT; const float* sinT;
    __device__ __forceinline__ void operator()(const f32x4 (&acc)[2][2][4][2], const Unit& u, int wr, int wc, int fr, int fq) const {
        const int row0 = u.pm * BM + wr * 64 + fr;
        if (u.pn >= 3) {
            bf16_t* base = BG + (size_t)((u.pn - 3) >> 1) * ((size_t)MTOK * CONVW);
            const int col0 = ((u.pn - 3) & 1) * 256 + wc * 32 + 8 * fq;
#pragma unroll
            for (int ai = 0; ai < 2; ++ai)
#pragma unroll
                for (int m = 0; m < 4; ++m) { bf16_t* rowp = base + (size_t)(row0 + ai * HALF + m * 16) * CONVW + col0;
#pragma unroll
                    for (int bj = 0; bj < 2; ++bj) { const f32x4 v0 = acc[ai][bj][m][0], v1 = acc[ai][bj][m][1];
                        u32x4 w; w.x = cvt_pk_bf16(v0[0], v0[1]); w.y = cvt_pk_bf16(v0[2], v0[3]); w.z = cvt_pk_bf16(v1[0], v1[1]); w.w = cvt_pk_bf16(v1[2], v1[3]);
                        *(u32x4*)(rowp + bj * HALF) = w; } }
        } else if (u.pn < 2) {
            const int dbase = 16 * (wc & 1) + 4 * fq;
#pragma unroll
            for (int ai = 0; ai < 2; ++ai)
#pragma unroll
                for (int m = 0; m < 4; ++m) { const int r = row0 + ai * HALF + m * 16, t = r & (SEQ - 1), pos = (wc & 1) ? (t & 63) : (t >> 6);
                    const f32x4 cs = *(const f32x4*)(cosT + pos * 16 + 4 * fq), sn = *(const f32x4*)(sinT + pos * 16 + 4 * fq);
#pragma unroll
                    for (int bj = 0; bj < 2; ++bj) { const f32x4 x1 = acc[ai][bj][m][0], x2 = acc[ai][bj][m][1];
                        const f32x4 o1 = (x1 * cs - x2 * sn) * QSCALE, o2 = (x1 * sn + x2 * cs) * QSCALE;
                        bf16_t* p = Q + (size_t)r * ATTW + (u.pn * 4 + bj * 2 + (wc >> 1)) * HDIM + dbase;
                        u32x2 a, b; a.x = cvt_pk_bf16(o1[0], o1[1]); a.y = cvt_pk_bf16(o1[2], o1[3]); b.x = cvt_pk_bf16(o2[0], o2[1]); b.y = cvt_pk_bf16(o2[2], o2[3]);
                        *(u32x2*)p = a; *(u32x2*)(p + 32) = b; }
                    asm volatile("" ::: "memory"); }
        } else {
            const bool is_ctx = u.pm >= MTOK / BM; const int dbase = 16 * (wc & 1) + 4 * fq, kvh = wc >> 1;
#pragma unroll
            for (int ai = 0; ai < 2; ++ai)
#pragma unroll
                for (int m = 0; m < 4; ++m) { const int r = row0 + ai * HALF + m * 16; int b, kvrow; f32x4 o1 = acc[ai][0][m][0], o2 = acc[ai][0][m][1];
                    if (!is_ctx) { b = r >> 13; const int t = r & (SEQ - 1), pos = (wc & 1) ? (t & 63) : (t >> 6); kvrow = CTXL + t;
                        const f32x4 cs = *(const f32x4*)(cosT + pos * 16 + 4 * fq), sn = *(const f32x4*)(sinT + pos * 16 + 4 * fq);
                        const f32x4 x1 = o1, x2 = o2; o1 = x1 * cs - x2 * sn; o2 = x1 * sn + x2 * cs; }
                    else { const int rr = r - MTOK; b = rr >> 8; kvrow = rr & (CTXL - 1); }
                    bf16_t* p = Kb + ((size_t)(b * NKVH + kvh) * KVROWS + kvrow) * HDIM + dbase;
                    u32x2 a, c2; a.x = cvt_pk_bf16(o1[0], o1[1]); a.y = cvt_pk_bf16(o1[2], o1[3]); c2.x = cvt_pk_bf16(o2[0], o2[1]); c2.y = cvt_pk_bf16(o2[2], o2[3]);
                    *(u32x2*)p = a; *(u32x2*)(p + 32) = c2;
                    bf16_t* vp = Vt + ((size_t)(b * NKVH + kvh) * HDIM + 32 * (wc & 1) + 8 * fq) * KVROWS + kvrow;
#pragma unroll
                    for (int n = 0; n < 2; ++n) { const f32x4 v = acc[ai][1][m][n]; const unsigned w0 = cvt_pk_bf16(v[0], v[1]), w1 = cvt_pk_bf16(v[2], v[3]);
                        vp[(size_t)(4 * n + 0) * KVROWS] = (bf16_t)(w0 & 0xffffu); vp[(size_t)(4 * n + 1) * KVROWS] = (bf16_t)(w0 >> 16);
                        vp[(size_t)(4 * n + 2) * KVROWS] = (bf16_t)(w1 & 0xffffu); vp[(size_t)(4 * n + 3) * KVROWS] = (bf16_t)(w1 >> 16); }
                    asm volatile("" ::: "memory"); }
        }
    }
};
struct EpiOutProj {
    static constexpr bool PERM = false, AFTER_DRAIN = false;
    const float* x; float* x1; const float* modf;
    __device__ __forceinline__ void operator()(const f32x4 (&acc)[2][2][4][2], const Unit& u, int wr, int wc, int fr, int fq) const {
        const int row0 = u.pm * BM + wr * 64 + fr, col0 = u.pn * BM + wc * 32 + 4 * fq, b = (u.pm * BM) >> 13;
        f32x4 gt[2][2];
#pragma unroll
        for (int bj = 0; bj < 2; ++bj)
#pragma unroll
            for (int n = 0; n < 2; ++n) gt[bj][n] = *(const f32x4*)(modf + (size_t)b * 6 * DM + 2 * DM + col0 + bj * HALF + n * 16);
#pragma unroll
        for (int ai = 0; ai < 2; ++ai)
#pragma unroll
            for (int m = 0; m < 4; ++m) { const size_t off = (size_t)(row0 + ai * HALF + m * 16) * DM + col0;
#pragma unroll
                for (int bj = 0; bj < 2; ++bj)
#pragma unroll
                    for (int n = 0; n < 2; ++n) { const f32x4 xv = *(const f32x4*)(x + off + bj * HALF + n * 16); *(f32x4*)(x1 + off + bj * HALF + n * 16) = xv + gt[bj][n] * acc[ai][bj][m][n]; } }
    }
};
struct EpiGateUp {
    static constexpr bool PERM = true, AFTER_DRAIN = false;
    bf16_t* act;
    __device__ __forceinline__ void operator()(const f32x4 (&acc)[2][2][4][2], const Unit& u, int wr, int wc, int fr, int fq) const {
        const int row0 = u.pm * BM + wr * 64 + fr, col0 = (u.pn & 7) * HALF + wc * 32 + 8 * fq;
#pragma unroll
        for (int ai = 0; ai < 2; ++ai)
#pragma unroll
            for (int m = 0; m < 4; ++m) { float o[8];
#pragma unroll
                for (int n = 0; n < 2; ++n)
#pragma unroll
                    for (int i = 0; i < 4; ++i) { const float g = acc[ai][0][m][n][i], up = acc[ai][1][m][n][i];
                        o[4 * n + i] = g * up * __builtin_amdgcn_rcpf(1.0f + __builtin_amdgcn_exp2f(-1.4426950408889634f * g)); }
                u32x4 w; w.x = cvt_pk_bf16(o[0], o[1]); w.y = cvt_pk_bf16(o[2], o[3]); w.z = cvt_pk_bf16(o[4], o[5]); w.w = cvt_pk_bf16(o[6], o[7]);
                *(u32x4*)(act + (size_t)(row0 + ai * HALF + m * 16) * DEXP + col0) = w; }
    }
};
struct EpiDown {
    static constexpr bool PERM = true, AFTER_DRAIN = false;
    bf16_t* y; const float* gsel;
    __device__ __forceinline__ void operator()(const f32x4 (&acc)[2][2][4][2], const Unit& u, int wr, int wc, int fr, int fq) const {
        const int row0 = u.pm * BM + wr * 64 + fr, col0 = (u.pn & 3) * BM + wc * 32 + 8 * fq;
#pragma unroll
        for (int ai = 0; ai < 2; ++ai)
#pragma unroll
            for (int m = 0; m < 4; ++m) { const int r = row0 + ai * HALF + m * 16; const float g = gsel[r];
#pragma unroll
                for (int bj = 0; bj < 2; ++bj) { const f32x4 v0 = acc[ai][bj][m][0] * g, v1 = acc[ai][bj][m][1] * g;
                    u32x4 w; w.x = cvt_pk_bf16(v0[0], v0[1]); w.y = cvt_pk_bf16(v0[2], v0[3]); w.z = cvt_pk_bf16(v1[0], v1[1]); w.w = cvt_pk_bf16(v1[2], v1[3]);
                    *(u32x4*)(y + (size_t)r * DM + col0 + bj * HALF) = w; } }
    }
};
}
#ifndef PG8_SP2
#define PG8_SP2 true
#endif
#ifndef PG8_ALIGN
#define PG8_ALIGN true
#endif

constexpr int NWAVES = 8;
constexpr int NPH = 10;
#ifndef MK_N_LAUNCHES
#define MK_N_LAUNCHES 1
#endif
constexpr int N_LAUNCHES = MK_N_LAUNCHES;
static_assert(N_LAUNCHES == 1 || N_LAUNCHES == NPH, "MK_N_LAUNCHES is 1 or 10");

constexpr size_t MiB = 1u << 20;
constexpr size_t WS_CTL = 0, CTL_ZERO_BYTES = 64 * 1024;
constexpr size_t WS_MODP = 1 * MiB;
constexpr size_t WS_MODF = 2 * MiB + 512 * 1024;
constexpr size_t WS_ROPE = 2 * MiB + 768 * 1024;
constexpr size_t WS_AFF = 3 * MiB;
constexpr size_t WS_GSEL = 4 * MiB;
constexpr size_t WS_ROWIDX = 4 * MiB + 256 * 1024;
constexpr size_t WS_SEL = 5 * MiB;
constexpr size_t WS_WIN = 6 * MiB, WS_WO = 11 * MiB;
constexpr size_t WS_WGU = 16 * MiB, WS_WD = 80 * MiB;
constexpr size_t WS_XN = 112 * MiB;
constexpr size_t WS_MIX = 112 * MiB;
constexpr size_t WS_H2 = 146 * MiB;
constexpr size_t WS_ACT = 178 * MiB;
constexpr size_t WS_Q = 178 * MiB, WS_K = 194 * MiB, WS_VT = 198 * MiB + 512 * 1024, WS_BG = 203 * MiB, WS_CG = 219 * MiB, WS_HV = 235 * MiB;
constexpr size_t WS_Y = 112 * MiB;
constexpr size_t WS_END = 251 * MiB;
static_assert(WS_K + (size_t)BATCH * NKVH * KVROWS * HDIM * 2 <= WS_VT && WS_VT + (size_t)BATCH * NKVH * KVROWS * HDIM * 2 <= WS_BG, "K / V^T buffers");
static_assert(WS_XN + (size_t)MALL * DM * 2 <= WS_H2 && WS_H2 + (size_t)MTOK * DM * 2 <= WS_Q && WS_ACT + (size_t)NEXP * 2 * CAP * DM * 2 <= WS_END && WS_Y + (size_t)NEXP * 2 * CAP * DM * 2 <= WS_Q, "d_ws map");
constexpr int CW_BAR = 1024;
constexpr int RING_OFF = 0, RING_BYTES = 131072;
constexpr int LDSCTL_OFF = RING_BYTES, MISC_OFF = LDSCTL_OFF + 320;
constexpr int LDS_BYTES = 147456;

#define GAS __attribute__((address_space(1)))
#define LAS __attribute__((address_space(3)))
typedef unsigned short bf16;
typedef unsigned v4u __attribute__((ext_vector_type(4)));
typedef unsigned v2u __attribute__((ext_vector_type(2)));
typedef float f32x4 __attribute__((ext_vector_type(4)));
typedef float f32x16 __attribute__((ext_vector_type(16)));
typedef short bf16x8 __attribute__((ext_vector_type(8)));
typedef GAS unsigned gu32;
#define RLX_AGENT __ATOMIC_RELAXED, __HIP_MEMORY_SCOPE_AGENT
#define LDS_WAIT() asm volatile("s_waitcnt lgkmcnt(0)" ::: "memory")
#define VM_WAIT() asm volatile("s_waitcnt vmcnt(0)" ::: "memory")
__device__ __forceinline__ unsigned f2bf(float f) { unsigned u = __builtin_bit_cast(unsigned, f); return (u + 0x7fffu + ((u >> 16) & 1u)) >> 16; }
__device__ __forceinline__ unsigned pk2(float lo, float hi) { return f2bf(lo) | (f2bf(hi) << 16); }
__device__ __forceinline__ float bflo(unsigned w) { return __uint_as_float(w << 16); }
__device__ __forceinline__ float bfhi(unsigned w) { return __uint_as_float(w & 0xffff0000u); }
#define XB_TMO      128
#define XB_XCNT(j)  (256  + 64 * (j))
#define XB_XSUB(j)  (1280 + 64 * (j))
#define XB_XGEN(j)  (2304 + 64 * (j))
#define XB_TOP      3328
#define XB_TOPGEN   3392
#define XCD_BAR_WORDS 3456
#define XB_SPIN_CAP (1u << 18)

__device__ __forceinline__ unsigned xb_ld(unsigned* p)              { return __hip_atomic_load(p, __ATOMIC_RELAXED, __HIP_MEMORY_SCOPE_AGENT); }
__device__ __forceinline__ unsigned xb_add(unsigned* p, unsigned v) { return __hip_atomic_fetch_add(p, v, __ATOMIC_RELAXED, __HIP_MEMORY_SCOPE_AGENT); }
__device__ __forceinline__ unsigned xb_xcc_id() { return (unsigned)__builtin_amdgcn_s_getreg((3 << 11) | 20) & 0xFu; }
#define XB_SPIN(cond, bar) do { unsigned _sp = 0; while (cond) { __builtin_amdgcn_s_sleep(1); \
    if ((++_sp & 255u) == 0u) { if (xb_ld(&(bar)[XB_TMO])) break; if (_sp > XB_SPIN_CAP) { atomicAdd(&(bar)[XB_TMO], 1u); break; } } } } while (0)

struct XcdBarrier {
    unsigned* bar; unsigned x;
    volatile LAS unsigned* st;
    int w;
};

__device__ __forceinline__ int xb_lane() { int l; asm volatile("v_mbcnt_lo_u32_b32 %0, -1, 0\n\tv_mbcnt_hi_u32_b32 %0, -1, %0" : "=v"(l)); return l; }
#define MY_TID0() (b.w == 0 && xb_lane() == 0)
__device__ __forceinline__ XcdBarrier xcd_barrier_post(unsigned* bar, volatile LAS unsigned* st, int w) {
    XcdBarrier b; b.bar = bar; b.x = xb_xcc_id(); b.st = st; b.w = w;
    if (MY_TID0()) (void)xb_add(&bar[XB_XCNT(b.x)], 1u);
    return b;
}
__device__ __forceinline__ void xcd_barrier_complete(unsigned* bar, unsigned x, unsigned& nloc, unsigned& nx) {
    const unsigned G = gridDim.x * gridDim.y * gridDim.z;
    unsigned sum, cnt, mine, sp = 0u;
    for (;;) {
        sum = 0u; cnt = 0u; mine = 0u;
#pragma unroll
        for (unsigned j = 0; j < 16; ++j) { const unsigned c = xb_ld(&bar[XB_XCNT(j)]); sum += c; cnt += (c > 0u) ? 1u : 0u; mine = (j == x) ? c : mine; }
        if (sum == G) break;
        __builtin_amdgcn_s_sleep(1);
        if ((++sp & 255u) == 0u) { if (xb_ld(&bar[XB_TMO])) break; if (sp > XB_SPIN_CAP) { atomicAdd(&bar[XB_TMO], 1u); break; } }
    }
    nloc = mine > 0u ? mine : 1u; nx = cnt > 0u ? cnt : 1u;
}

__device__ __forceinline__ void xcd_barrier(const XcdBarrier& b) {
    asm volatile("s_waitcnt vmcnt(0)" ::: "memory");
    __syncthreads();
    if (MY_TID0()) {
        unsigned* bar = b.bar;
        __builtin_amdgcn_s_waitcnt(0);
        unsigned nloc = b.st[0], nx = b.st[1];
        if (nloc == 0u) { xcd_barrier_complete(bar, b.x, nloc, nx); b.st[0] = nloc; b.st[1] = nx; }
        const unsigned old = xb_add(&bar[XB_XSUB(b.x)], 1u);
        const unsigned gen = old / nloc;
        if (old + 1u == (gen + 1u) * nloc) {
            __builtin_amdgcn_fence(__ATOMIC_RELEASE, "agent");
            asm volatile("s_waitcnt vmcnt(0)" ::: "memory");
            const unsigned og = xb_add(&bar[XB_TOP], 1u);
            const unsigned tg = og / nx;
            if (og + 1u == (tg + 1u) * nx) xb_add(&bar[XB_TOPGEN], 1u);
            else XB_SPIN(xb_ld(&bar[XB_TOPGEN]) == tg, bar);
            __builtin_amdgcn_fence(__ATOMIC_ACQUIRE, "agent");
            xb_add(&bar[XB_XGEN(b.x)], 1u);
            asm volatile("s_waitcnt vmcnt(0)" ::: "memory");
        } else {
            XB_SPIN(xb_ld(&bar[XB_XGEN(b.x)]) == gen, bar);
            __builtin_amdgcn_fence(__ATOMIC_ACQUIRE, "agent");
            asm volatile("s_waitcnt vmcnt(0)" ::: "memory");
        }
    }
    __syncthreads();
}

__device__ __forceinline__ int lane_id() { int l; asm volatile("v_mbcnt_lo_u32_b32 %0, -1, 0\n\tv_mbcnt_hi_u32_b32 %0, -1, %0" : "=v"(l)); return l; }
struct Frame {
    LAS unsigned char* lds;
    volatile LAS unsigned* MISC;
    gu32* ctl;
    int wave, vcu, G;
    const float *x, *c, *ctx, *c_ctx, *w_ada, *b_ada, *g_mix, *w_in, *conv_w, *sink, *w_out, *g_ffn, *w_router, *w_gate, *w_up, *w_down, *g_final;
    float* out; unsigned char* ws;
};
__device__ __forceinline__ int ftid(const Frame& F) { return F.wave * 64 + lane_id(); }
__device__ __forceinline__ float wave_sum(float v) {
#pragma unroll
    for (int o = 1; o < 64; o <<= 1) v += __shfl_xor(v, o);
    return v;
}
typedef float f32x2_t __attribute__((ext_vector_type(2))); typedef __bf16 bf16x2_t __attribute__((ext_vector_type(2)));
__device__ __forceinline__ unsigned cvtpk(float lo, float hi) { f32x2_t v = {lo, hi}; bf16x2_t b = __builtin_convertvector(v, bf16x2_t); return __builtin_bit_cast(unsigned, b); }

template <int MODE> __device__ __forceinline__ int wt_row(int n, int row_off) {
    if (MODE == 0) return row_off + n;
    if (MODE == 1) { if (n >= ATTW + KVW) return n; const int d = n & 63; return (n & ~63) + 8 * ((d & 31) >> 2) + 4 * (d >> 5) + (d & 3); }
    return row_off + (n >> 7) * 256 + (n & 127) + (MODE == 3 ? 128 : 0);
}
template <int MODE> __device__ __forceinline__ void p0_transpose_item(const float* W, int K, int N, bf16* WT, int row_off, LAS float* scr, int item, int lane) {
    const int nblk = N / 32, kb = item / nblk, nb = item % nblk, k0 = 64 * kb, n0 = 32 * nb;
#pragma unroll 8
    for (int i = 0; i < 32; ++i) { const int kk = 2 * i + (lane >> 5); scr[kk * 33 + (lane & 31)] = W[(size_t)(k0 + kk) * N + n0 + (lane & 31)]; }
    LDS_WAIT(); asm volatile("" ::: "memory");
    const int c = lane & 7;
#pragma unroll
    for (int j = 0; j < 4; ++j) { const int n = (lane >> 3) + 8 * j; const LAS float* s = scr + (8 * c) * 33 + n;
        v4u o; o.x = pk2(s[0 * 33], s[1 * 33]); o.y = pk2(s[2 * 33], s[3 * 33]); o.z = pk2(s[4 * 33], s[5 * 33]); o.w = pk2(s[6 * 33], s[7 * 33]);
        *(GAS v4u*)(WT + (size_t)wt_row<MODE>(n0 + n, row_off) * K + k0 + 8 * c) = o; }
    LDS_WAIT(); asm volatile("" ::: "memory");
}
__device__ __forceinline__ void p0_prologue(Frame& F) {
    const int lane = lane_id(), tid = F.wave * 64 + lane;
    LAS float* sil = (LAS float*)(F.lds + LDSCTL_OFF + 1024);
    float* MODP = (float*)(F.ws + WS_MODP);
    for (int task = F.vcu; task < 192; task += F.G) {
        const int kc = task / 12, jb = task % 12;
        __syncthreads();
        if (tid < 192) { const int v = tid >> 6, k = kc * 64 + (tid & 63); const float cv = (v < 2) ? F.c[v * DM + k] : F.c_ctx[k]; sil[tid] = cv / (1.0f + __expf(-cv)); }
        __syncthreads();
        const int j = jb * 512 + tid; const float* wp = F.w_ada + (size_t)(kc * 64) * (6 * DM) + j; float a0 = 0.f, a1 = 0.f, a2 = 0.f;
#pragma unroll 16
        for (int kk = 0; kk < 64; ++kk) { const float w = wp[(size_t)kk * (6 * DM)]; a0 += sil[kk] * w; a1 += sil[64 + kk] * w; a2 += sil[128 + kk] * w; }
        MODP[(size_t)(kc * 3 + 0) * (6 * DM) + j] = a0; MODP[(size_t)(kc * 3 + 1) * (6 * DM) + j] = a1; MODP[(size_t)(kc * 3 + 2) * (6 * DM) + j] = a2;
    }
    if (F.vcu == (192 % F.G)) {
        float* cosT = (float*)(F.ws + WS_ROPE); float* sinT = cosT + 128 * 16;
        for (int i = tid; i < 2048; i += NWAVES * 64) { const int pos = i >> 4, f = i & 15;
            const double b4 = (f & 3) == 0 ? 1.0 : ((f & 3) == 1 ? 0.5623413251903491 : ((f & 3) == 2 ? 0.31622776601683794 : 0.1778279410038923));
            const double p10 = (f >> 2) == 0 ? 1.0 : ((f >> 2) == 1 ? 0.1 : ((f >> 2) == 2 ? 0.01 : 0.001));
            const double ang = (double)pos * (b4 * p10); const double kq = __builtin_rint(ang * 0.6366197723675814);
            const double r = (ang - kq * 1.5707963267948966) - kq * 6.123233995736766e-17; const int q = ((int)kq) & 3; const double r2 = r * r;
            const double s = r * (1.0 + r2 * (-1.0 / 6 + r2 * (1.0 / 120 + r2 * (-1.0 / 5040 + r2 * (1.0 / 362880 + r2 * (-1.0 / 39916800 + r2 * (1.0 / 6227020800.0)))))));
            const double c = 1.0 + r2 * (-0.5 + r2 * (1.0 / 24 + r2 * (-1.0 / 720 + r2 * (1.0 / 40320 + r2 * (-1.0 / 3628800 + r2 * (1.0 / 479001600.0 + r2 * (-1.0 / 87178291200.0)))))));
            const double cc = q == 0 ? c : (q == 1 ? -s : (q == 2 ? -c : s)), ss = q == 0 ? s : (q == 1 ? c : (q == 2 ? -s : -c));
            cosT[i] = (float)cc; sinT[i] = (float)ss; }
    }
    __syncthreads();
    LAS float* scr = (LAS float*)(F.lds + RING_OFF + F.wave * 16384);
    const int gw = F.vcu * NWAVES + F.wave, NGW = F.G * NWAVES;
    constexpr int I_IN = (DM / 64) * (INW / 32), I_O = (DM / 64) * (DM / 32), I_E = (DM / 64) * (DEXP / 32);
    constexpr int NITEMS = I_IN + I_O + 3 * NEXP * I_E;
    bf16* WIN = (bf16*)(F.ws + WS_WIN); bf16* WO = (bf16*)(F.ws + WS_WO); bf16* WGU = (bf16*)(F.ws + WS_WGU); bf16* WD = (bf16*)(F.ws + WS_WD);
    for (int it = gw; it < NITEMS; it += NGW) {
        int r = it;
        if (r < I_IN) { p0_transpose_item<1>(F.w_in, DM, INW, WIN, 0, scr, r, lane); continue; } r -= I_IN;
        if (r < I_O) { p0_transpose_item<0>(F.w_out, DM, DM, WO, 0, scr, r, lane); continue; } r -= I_O;
        const int mat = r / (NEXP * I_E), rr = r % (NEXP * I_E), e = rr / I_E, ie = rr % I_E;
        if (mat == 0) p0_transpose_item<2>(F.w_gate + (size_t)e * DM * DEXP, DM, DEXP, WGU, e * 2 * DEXP, scr, ie, lane);
        else if (mat == 1) p0_transpose_item<3>(F.w_up + (size_t)e * DM * DEXP, DM, DEXP, WGU, e * 2 * DEXP, scr, ie, lane);
        else p0_transpose_item<0>(F.w_down + (size_t)e * DEXP * DM, DEXP, DM, WD, e * DM, scr, ie, lane);
    }
}

__device__ __forceinline__ float mod_sum(const float* MODP, const float* b_ada, int v, int col) {
    float s = b_ada[col];
#pragma unroll
    for (int kc = 0; kc < 16; ++kc) s += MODP[(size_t)(kc * 3 + v) * (6 * DM) + col];
    return s;
}
__device__ __forceinline__ void p1_norm(Frame& F) {
    const int lane = lane_id(), tid = F.wave * 64 + lane;
    const float* MODP = (const float*)(F.ws + WS_MODP); float* MODF = (float*)(F.ws + WS_MODF);
    LAS float* tA = (LAS float*)(F.lds); LAS float* tB = tA + 3 * DM;
    for (int idx = tid; idx < 3 * 2 * DM; idx += NWAVES * 64) { const int v = idx / (2 * DM), q = idx % (2 * DM); const float s = mod_sum(MODP, F.b_ada, v, q);
        if (q < DM) tB[v * DM + q] = s; else tA[v * DM + q - DM] = F.g_mix[q - DM] * (1.0f + s); }
    for (int o = F.vcu * (NWAVES * 64) + tid; o < 3 * 6 * DM; o += F.G * NWAVES * 64) MODF[o] = mod_sum(MODP, F.b_ada, o / (6 * DM), o % (6 * DM));
    __syncthreads();
    bf16* XN = (bf16*)(F.ws + WS_XN);
    const int gw = F.vcu * NWAVES + F.wave, NGW = F.G * NWAVES;
    for (int m = gw; m < MALL; m += NGW) {
        const int v = m < SEQ ? 0 : (m < MTOK ? 1 : 2);
        const float* src = m < MTOK ? F.x + (size_t)m * DM : F.ctx + (size_t)(m - MTOK) * DM;
        const GAS f32x4* xr = (const GAS f32x4*)src + lane;
        f32x4 xv[4]; float ss = 0.f;
#pragma unroll
        for (int j = 0; j < 4; ++j) { xv[j] = xr[64 * j]; ss += (xv[j].x * xv[j].x + xv[j].y * xv[j].y) + (xv[j].z * xv[j].z + xv[j].w * xv[j].w); }
        const float rstd = 1.0f / sqrtf(wave_sum(ss) * (1.0f / DM) + EPS_RMS);
        GAS unsigned long long* o8 = (GAS unsigned long long*)(XN + (size_t)m * DM) + lane;
#pragma unroll
        for (int j = 0; j < 4; ++j) { const f32x4 a = *(const LAS f32x4*)(tA + v * DM + 4 * lane + 256 * j), sh = *(const LAS f32x4*)(tB + v * DM + 4 * lane + 256 * j);
            const f32x4 h = xv[j] * rstd * a + sh;
            o8[64 * j] = (unsigned long long)cvtpk(h.x, h.y) | ((unsigned long long)cvtpk(h.z, h.w) << 32); }
    }
}

#define MFMA32(a, b, c) __builtin_amdgcn_mfma_f32_32x32x16_bf16((a), (b), (c), 0, 0, 0)
__device__ __forceinline__ int crow(int r, int hi) { return (r & 3) + 8 * (r >> 2) + 4 * hi; }
__device__ __forceinline__ bf16x8 pack8(const f32x16& p, int s) {
    v4u w; w.x = cvtpk(p[8 * s + 0], p[8 * s + 1]); w.y = cvtpk(p[8 * s + 2], p[8 * s + 3]); w.z = cvtpk(p[8 * s + 4], p[8 * s + 5]); w.w = cvtpk(p[8 * s + 6], p[8 * s + 7]);
    return __builtin_bit_cast(bf16x8, w);
}
constexpr int ATT_KBUF = 0, ATT_VBUF = 8192, ATT_BUF = 16384;
__device__ __forceinline__ void attn_unit(Frame& F, int u) {
    const int b = u >> 7, kvh = (u >> 6) & 1, n = u & 63;
    const int lane = lane_id(), tid = F.wave * 64 + lane, r32 = lane & 31, hh = lane >> 5, g = F.wave >> 1, half = F.wave & 1, h = kvh * 4 + g;
    const bf16* Q = (const bf16*)(F.ws + WS_Q); bf16* MIX = (bf16*)(F.ws + WS_MIX);
    const bf16* Kbase = (const bf16*)(F.ws + WS_K) + (size_t)(b * NKVH + kvh) * KVROWS * HDIM;
    const bf16* Vbase = (const bf16*)(F.ws + WS_VT) + (size_t)(b * NKVH + kvh) * HDIM * KVROWS;
    const float sk2 = F.sink[h] * 1.4426950408889634f;
    const int q0 = n * 128 + half * 64;
    const int ntiles = (n == 0 || n == SEQ / 128 - 1) ? 8 : 10, tskip = (n == 0) ? 2 : 0;
    const int srow = tid >> 3, sc = tid & 7;
    const unsigned kw_off = (unsigned)(srow * 128 + ((sc ^ ((srow >> 1) & 7)) << 4));
    const int vg = (srow >> 1) & 15; const unsigned vw_off = (unsigned)(srow * 128 + ((sc ^ (vg >> 1)) << 4)); const bool vswap = (vg & 1) != 0;
    v4u kreg, vreg;
#define ATT_TILE_ROW(idx) (((idx) < 4) ? (idx) * 64 : CTXL + n * 128 - 128 + ((idx) + tskip - 4) * 64)
#define ATT_LOAD(idx) do { const int kr_ = ATT_TILE_ROW(idx); kreg = *(const v4u*)(Kbase + (size_t)kr_ * HDIM + tid * 8); vreg = *(const v4u*)(Vbase + (size_t)srow * KVROWS + kr_ + sc * 8); } while (0)
#define ATT_STORE(bufi) do { LAS unsigned char* tb_ = F.lds + (bufi) * ATT_BUF; *(LAS v4u*)(tb_ + ATT_KBUF + kw_off) = kreg; \
        v4u vv_ = vreg; if (vswap) { vv_.x = vreg.z; vv_.y = vreg.w; vv_.z = vreg.x; vv_.w = vreg.y; } *(LAS v4u*)(tb_ + ATT_VBUF + vw_off) = vv_; } while (0)
    __syncthreads();
    ATT_LOAD(0);
    LAS unsigned char* qlds = F.lds + 2 * ATT_BUF + F.wave * 8192 + lane * 16;
#pragma unroll
    for (int sb = 0; sb < 2; ++sb)
#pragma unroll
        for (int s = 0; s < 4; ++s) *(LAS bf16x8*)(qlds + (sb * 4 + s) * 1024) = *(const bf16x8*)(Q + (size_t)(b * SEQ + q0 + sb * 32 + r32) * ATTW + h * HDIM + 16 * s + 8 * hh);
    f32x16 o[2][2]; float mrun[2], lrun[2];
#pragma unroll
    for (int sb = 0; sb < 2; ++sb) { mrun[sb] = sk2; lrun[sb] = hh == 0 ? 1.0f : 0.0f;
#pragma unroll
        for (int db = 0; db < 2; ++db)
#pragma unroll
            for (int i = 0; i < 16; ++i) o[sb][db][i] = 0.f; }
    ATT_STORE(0);
    __syncthreads();
    unsigned kro[2];
#pragma unroll
    for (int kb = 0; kb < 2; ++kb) { const int row = kb * 32 + r32; kro[kb] = (unsigned)(ATT_KBUF + row * 128); }
    const int ksw = (r32 >> 1) & 7;
    const int vsw = (r32 >> 1) & 15;
    for (int idx = 0; idx < ntiles; ++idx) {
        const int cur = idx & 1;
        if (idx + 1 < ntiles) ATT_LOAD(idx + 1);
        const LAS unsigned char* tb = F.lds + cur * ATT_BUF;
        bf16x8 kf[2][4], vf[2][4];
#pragma unroll
        for (int kb = 0; kb < 2; ++kb)
#pragma unroll
            for (int s = 0; s < 4; ++s) kf[kb][s] = *(const LAS bf16x8*)(tb + kro[kb] + (((2 * s + hh) ^ ksw) << 4));
#pragma unroll
        for (int db = 0; db < 2; ++db)
#pragma unroll
            for (int ks = 0; ks < 4; ++ks) { const LAS unsigned char* vr = tb + ATT_VBUF + (db * 32 + r32) * 128;
                const v2u lo = *(const LAS v2u*)(vr + (((4 * ks + hh) ^ vsw) << 3)), hi = *(const LAS v2u*)(vr + (((4 * ks + 2 + hh) ^ vsw) << 3));
                v4u w; w.x = lo.x; w.y = lo.y; w.z = hi.x; w.w = hi.y; vf[db][ks] = __builtin_bit_cast(bf16x8, w); }
        const int tile = idx < 4 ? idx : idx + tskip;
        const bool needmask = tile >= 4 && (tile < 6 || tile >= 8);
        const int kpos0 = n * 128 - 128 + (tile - 4) * 64;
#pragma unroll
        for (int sb = 0; sb < 2; ++sb) {
            f32x16 p0, p1;
#pragma unroll
            for (int i = 0; i < 16; ++i) { p0[i] = 0.f; p1[i] = 0.f; }
#pragma unroll
            for (int s = 0; s < 4; ++s) { const bf16x8 qv = *(const LAS bf16x8*)(qlds + (sb * 4 + s) * 1024); p0 = MFMA32(kf[0][s], qv, p0); p1 = MFMA32(kf[1][s], qv, p1); }
            if (needmask) { const int qpos = q0 + sb * 32 + r32;
#pragma unroll
                for (int i = 0; i < 16; ++i) { const int dk = kpos0 + crow(i, hh) - qpos; if (dk > 128 || dk < -128) p0[i] = -1e30f; if (dk + 32 > 128 || dk + 32 < -128) p1[i] = -1e30f; } }
            float mx = fmaxf(p0[0], p1[0]);
#pragma unroll
            for (int i = 1; i < 16; ++i) mx = fmaxf(mx, fmaxf(p0[i], p1[i]));
            mx = fmaxf(mx, __shfl_xor(mx, 32));
            const float mold = mrun[sb], mnew = fmaxf(mold, mx); mrun[sb] = mnew;
            if (__any(mnew > mold)) { const float alpha = __builtin_amdgcn_exp2f(mold - mnew); lrun[sb] *= alpha;
#pragma unroll
                for (int db = 0; db < 2; ++db)
#pragma unroll
                    for (int i = 0; i < 16; ++i) o[sb][db][i] *= alpha; }
            float ps = 0.f;
#pragma unroll
            for (int i = 0; i < 16; ++i) { p0[i] = __builtin_amdgcn_exp2f(p0[i] - mnew); p1[i] = __builtin_amdgcn_exp2f(p1[i] - mnew); ps += p0[i] + p1[i]; }
            lrun[sb] += ps;
            bf16x8 pb[4]; pb[0] = pack8(p0, 0); pb[1] = pack8(p0, 1); pb[2] = pack8(p1, 0); pb[3] = pack8(p1, 1);
#pragma unroll
            for (int db = 0; db < 2; ++db)
#pragma unroll
                for (int ks = 0; ks < 4; ++ks) o[sb][db] = MFMA32(vf[db][ks], pb[ks], o[sb][db]);
        }
        if (idx + 1 < ntiles) ATT_STORE(cur ^ 1);
        __syncthreads();
    }
#undef ATT_TILE_ROW
#undef ATT_LOAD
#undef ATT_STORE
#pragma unroll
    for (int sb = 0; sb < 2; ++sb) { const float lt = lrun[sb] + __shfl_xor(lrun[sb], 32), inv = 1.0f / lt;
        bf16* dst = MIX + (size_t)(b * SEQ + q0 + sb * 32 + r32) * DM + h * HDIM;
#pragma unroll
        for (int db = 0; db < 2; ++db)
#pragma unroll
            for (int g4 = 0; g4 < 4; ++g4) { v2u w; w.x = cvtpk(o[sb][db][4 * g4] * inv, o[sb][db][4 * g4 + 1] * inv); w.y = cvtpk(o[sb][db][4 * g4 + 2] * inv, o[sb][db][4 * g4 + 3] * inv);
                *(v2u*)(dst + db * 32 + 8 * g4 + 4 * hh) = w; } }
}
__device__ __forceinline__ void unpack8(const v4u w, float (&f)[8]) { f[0] = bflo(w.x); f[1] = bfhi(w.x); f[2] = bflo(w.y); f[3] = bfhi(w.y); f[4] = bflo(w.z); f[5] = bfhi(w.z); f[6] = bflo(w.w); f[7] = bfhi(w.w); }
__device__ __forceinline__ void p3_attn_conv(Frame& F) {
    const int tid = F.wave * 64 + lane_id();
    for (int u = F.vcu; u < BATCH * NKVH * (SEQ / 128); u += F.G) attn_unit(F, u);
    const bf16* BG = (const bf16*)(F.ws + WS_BG); const bf16* CG = (const bf16*)(F.ws + WS_CG); const bf16* HV = (const bf16*)(F.ws + WS_HV); bf16* MIX = (bf16*)(F.ws + WS_MIX);
    for (int idx = F.vcu * (NWAVES * 64) + tid; idx < MTOK * (CONVW / 8); idx += F.G * NWAVES * 64) {
        const int row = idx >> 6, c8 = (idx & 63) * 8, t = row & (SEQ - 1); const size_t off = (size_t)row * CONVW + c8;
        float bgv[8], uc[8], up[8], un[8], a[8], bq[8];
        unpack8(*(const v4u*)(BG + off), bgv);
        unpack8(*(const v4u*)(CG + off), a); unpack8(*(const v4u*)(HV + off), bq);
#pragma unroll
        for (int i = 0; i < 8; ++i) uc[i] = a[i] * bq[i];
        if (t > 0) { unpack8(*(const v4u*)(CG + off - CONVW), a); unpack8(*(const v4u*)(HV + off - CONVW), bq);
#pragma unroll
            for (int i = 0; i < 8; ++i) up[i] = a[i] * bq[i]; }
        else {
#pragma unroll
            for (int i = 0; i < 8; ++i) up[i] = 0.f; }
        if (t < SEQ - 1) { unpack8(*(const v4u*)(CG + off + CONVW), a); unpack8(*(const v4u*)(HV + off + CONVW), bq);
#pragma unroll
            for (int i = 0; i < 8; ++i) un[i] = a[i] * bq[i]; }
        else {
#pragma unroll
            for (int i = 0; i < 8; ++i) un[i] = 0.f; }
        float r[8];
#pragma unroll
        for (int i = 0; i < 8; ++i) r[i] = bgv[i] * (F.conv_w[c8 + i] * up[i] + F.conv_w[CONVW + c8 + i] * uc[i] + F.conv_w[2 * CONVW + c8 + i] * un[i]);
        v4u w; w.x = cvtpk(r[0], r[1]); w.y = cvtpk(r[2], r[3]); w.z = cvtpk(r[4], r[5]); w.w = cvtpk(r[6], r[7]);
        *(v4u*)(MIX + (size_t)row * DM + ATTW + c8) = w;
    }
}

__device__ __forceinline__ void p5_norm_router(Frame& F) {
    const int lane = lane_id(), tid = F.wave * 64 + lane;
    const float* MODF = (const float*)(F.ws + WS_MODF);
    LAS float* wr = (LAS float*)(F.lds);
    LAS float* tA = wr + NEXP * DM; LAS float* tB = tA + 2 * DM;
    for (int i = tid; i < NEXP * DM; i += NWAVES * 64) { const int k = i >> 4, e = i & 15; wr[e * DM + k] = F.w_router[i]; }
    for (int i = tid; i < 2 * DM; i += NWAVES * 64) { const int b = i >> 10, k = i & (DM - 1);
        tA[i] = F.g_ffn[k] * (1.0f + MODF[(size_t)b * 6 * DM + 4 * DM + k]); tB[i] = MODF[(size_t)b * 6 * DM + 3 * DM + k]; }
    __syncthreads();
    bf16* H2 = (bf16*)(F.ws + WS_H2); float* AFF = (float*)(F.ws + WS_AFF);
    const int gw = F.vcu * NWAVES + F.wave, NGW = F.G * NWAVES;
    for (int m = gw; m < MTOK; m += NGW) {
        const int b = m >> 13, t = m & (SEQ - 1);
        const GAS f32x4* xr = (const GAS f32x4*)(F.out + (size_t)m * DM) + lane;
        f32x4 hv[4]; float ss = 0.f;
#pragma unroll
        for (int j = 0; j < 4; ++j) { hv[j] = xr[64 * j]; ss += (hv[j].x * hv[j].x + hv[j].y * hv[j].y) + (hv[j].z * hv[j].z + hv[j].w * hv[j].w); }
        const float rstd = 1.0f / sqrtf(wave_sum(ss) * (1.0f / DM) + EPS_RMS);
        GAS unsigned long long* o8 = (GAS unsigned long long*)(H2 + (size_t)m * DM) + lane;
#pragma unroll
        for (int j = 0; j < 4; ++j) { const f32x4 a = *(const LAS f32x4*)(tA + b * DM + 4 * lane + 256 * j), sh = *(const LAS f32x4*)(tB + b * DM + 4 * lane + 256 * j);
            hv[j] = hv[j] * rstd * a + sh;
            o8[64 * j] = (unsigned long long)cvtpk(hv[j].x, hv[j].y) | ((unsigned long long)cvtpk(hv[j].z, hv[j].w) << 32); }
        float r8[8];
#pragma unroll
        for (int e = 0; e < 8; ++e) { float s0 = 0.f, s1 = 0.f;
#pragma unroll
            for (int j = 0; j < 4; ++j) { const f32x4 w0 = *(const LAS f32x4*)(wr + e * DM + 4 * lane + 256 * j), w1 = *(const LAS f32x4*)(wr + (e + 8) * DM + 4 * lane + 256 * j);
                s0 += (hv[j].x * w0.x + hv[j].y * w0.y) + (hv[j].z * w0.z + hv[j].w * w0.w); s1 += (hv[j].x * w1.x + hv[j].y * w1.y) + (hv[j].z * w1.z + hv[j].w * w1.w); }
            const bool up = (lane & 32) != 0; r8[e] = (up ? s1 : s0) + __shfl_xor(up ? s0 : s1, 32);
            asm volatile("" ::: "memory"); }
        float r4[4], r2[2];
#pragma unroll
        for (int e = 0; e < 4; ++e) { const bool up = (lane & 16) != 0; r4[e] = (up ? r8[e + 4] : r8[e]) + __shfl_xor(up ? r8[e] : r8[e + 4], 16); }
#pragma unroll
        for (int e = 0; e < 2; ++e) { const bool up = (lane & 8) != 0; r2[e] = (up ? r4[e + 2] : r4[e]) + __shfl_xor(up ? r4[e] : r4[e + 2], 8); }
        float lg; { const bool up = (lane & 4) != 0; lg = (up ? r2[1] : r2[0]) + __shfl_xor(up ? r2[0] : r2[1], 4); }
        lg += __shfl_xor(lg, 2); lg += __shfl_xor(lg, 1);
        float mx = lg;
#pragma unroll
        for (int o = 4; o < 64; o <<= 1) mx = fmaxf(mx, __shfl_xor(mx, o));
        const float ex = __expf(lg - mx); float den = ex;
#pragma unroll
        for (int o = 4; o < 64; o <<= 1) den += __shfl_xor(den, o);
        const float mine = ex / den; const int myexp = ((lane >> 5) & 1) * 8 + ((lane >> 4) & 1) * 4 + ((lane >> 3) & 1) * 2 + ((lane >> 2) & 1);
        if ((lane & 3) == 0) AFF[(size_t)(b * NEXP + myexp) * SEQ + t] = mine;
    }
}

__device__ __forceinline__ int block_excl_scan(int v, LAS int* wsum, int lane, int wave, int& total) {
    int x = v;
#pragma unroll
    for (int o = 1; o < 64; o <<= 1) { const int y = __shfl_up(x, o); if (lane >= o) x += y; }
    if (lane == 63) wsum[wave] = x;
    __syncthreads();
    int base = 0, tot = 0;
#pragma unroll
    for (int w = 0; w < NWAVES; ++w) { const int s = wsum[w]; base += (w < wave) ? s : 0; tot += s; }
    __syncthreads();
    total = tot; return base + x - v;
}
__device__ __forceinline__ void p6_topk_task(Frame& F, int task) {
    const int b = task >> 7, e = (task >> 3) & 15, part = task & 7, lane = lane_id(), tid = F.wave * 64 + lane;
    LAS unsigned* keys = (LAS unsigned*)(F.lds);
    LAS unsigned* hist = (LAS unsigned*)(F.lds + 32768);
    LAS int* misc = (LAS int*)(F.lds + 32768 + 1024);
    const float* aff = (const float*)(F.ws + WS_AFF) + (size_t)(b * NEXP + e) * SEQ;
    __syncthreads();
    for (int i = tid; i < SEQ / 4; i += NWAVES * 64) *(LAS v4u*)(keys + 4 * i) = *(const v4u*)(aff + 4 * i);
    __syncthreads();
    unsigned prefix = 0u, mask = 0u; int kk = CAP;
    for (int pass = 3; pass >= 0; --pass) {
        if (tid < 256) hist[tid] = 0u;
        __syncthreads();
        const int sh = pass * 8;
#pragma unroll 4
        for (int j = 0; j < 16; ++j) { const unsigned k = keys[tid + 512 * j]; if ((k & mask) == prefix) __hip_atomic_fetch_add(hist + ((k >> sh) & 255u), 1u, __ATOMIC_RELAXED, __HIP_MEMORY_SCOPE_WORKGROUP); }
        __syncthreads();
        if (F.wave == 0) {
            const int c0 = (int)hist[255 - 4 * lane], c1 = (int)hist[254 - 4 * lane], c2 = (int)hist[253 - 4 * lane], c3 = (int)hist[252 - 4 * lane];
            const int s = c0 + c1 + c2 + c3; int incl = s;
#pragma unroll
            for (int o = 1; o < 64; o <<= 1) { const int y = __shfl_up(incl, o); if (lane >= o) incl += y; }
            const int excl = incl - s;
            if (excl < kk && incl >= kk) { const int r = kk - excl; int bin, above;
                if (r <= c0) { bin = 255 - 4 * lane; above = 0; } else if (r <= c0 + c1) { bin = 254 - 4 * lane; above = c0; }
                else if (r <= c0 + c1 + c2) { bin = 253 - 4 * lane; above = c0 + c1; } else { bin = 252 - 4 * lane; above = c0 + c1 + c2; }
                misc[0] = bin; misc[1] = r - above; }
        }
        __syncthreads();
        prefix |= (unsigned)misc[0] << sh; mask |= 255u << sh; kk = misc[1];
        __syncthreads();
    }
    const unsigned thr = prefix; const int need = kk;
    const int t0 = part * (SEQ / 8);
    int cgt = 0, ceq = 0;
#pragma unroll 4
    for (int j = 0; j < 16; ++j) { const int i = tid + 512 * j; const unsigned k = keys[i]; if (i < t0) { cgt += (k > thr) ? 1 : 0; ceq += (k == thr) ? 1 : 0; } }
    int gt_before, eq_before;
    (void)block_excl_scan(cgt, misc + 16, lane, F.wave, gt_before);
    (void)block_excl_scan(ceq, misc + 16, lane, F.wave, eq_before);
    const int tA = t0 + 2 * tid; const unsigned kA = keys[tA], kB = keys[tA + 1];
    const int eqA = (kA == thr) ? 1 : 0, eqB = (kB == thr) ? 1 : 0; int dummy;
    const int eqx = block_excl_scan(eqA + eqB, misc + 16, lane, F.wave, dummy);
    const int eposA = eq_before + eqx, eposB = eposA + eqA;
    const int selA = (kA > thr || (eqA && eposA < need)) ? 1 : 0, selB = (kB > thr || (eqB && eposB < need)) ? 1 : 0;
    int nloc;
    const int sx = block_excl_scan(selA + selB, misc + 16, lane, F.wave, nloc);
    const int sel_before = gt_before + (eq_before < need ? eq_before : need);
    int* SEL = (int*)(F.ws + WS_SEL); float* GSEL = (float*)(F.ws + WS_GSEL); int* ROWIDX = (int*)(F.ws + WS_ROWIDX);
    const int slotA = sel_before + sx, slotB = slotA + selA; const size_t eb = (size_t)(e * 2 + b) * CAP;
    SEL[(size_t)(b * SEQ + tA) * NEXP + e] = selA ? slotA : -1; SEL[(size_t)(b * SEQ + tA + 1) * NEXP + e] = selB ? slotB : -1;
    if (selA) { GSEL[eb + slotA] = __uint_as_float(kA); ROWIDX[eb + slotA] = b * SEQ + tA; }
    if (selB) { GSEL[eb + slotB] = __uint_as_float(kB); ROWIDX[eb + slotB] = b * SEQ + tA + 1; }
}

__device__ __forceinline__ void p9_final(Frame& F, float* dst_base) {
    const int lane = lane_id();
    const float* MODF = (const float*)(F.ws + WS_MODF); const int* SEL = (const int*)(F.ws + WS_SEL); const bf16* Y = (const bf16*)(F.ws + WS_Y);
    const int gw = F.vcu * NWAVES + F.wave, NGW = F.G * NWAVES;
    for (int m = gw; m < MTOK; m += NGW) {
        const int b = m >> 13;
        GAS f32x4* xr = (GAS f32x4*)(F.out + (size_t)m * DM) + lane;
        f32x4 xv[4], acc[4];
#pragma unroll
        for (int j = 0; j < 4; ++j) { xv[j] = xr[64 * j]; acc[j] = (f32x4){0.f, 0.f, 0.f, 0.f}; }
        const int selv = (lane < NEXP) ? SEL[(size_t)m * NEXP + lane] : -1;
#pragma unroll
        for (int e = 0; e < NEXP; ++e) { const int s = __builtin_amdgcn_readlane(selv, e);
            if (s >= 0) { const GAS v2u* yr = (const GAS v2u*)(Y + ((size_t)(e * 2 + b) * CAP + s) * DM) + lane;
#pragma unroll
                for (int j = 0; j < 4; ++j) { const v2u w = yr[64 * j]; acc[j].x += bflo(w.x); acc[j].y += bfhi(w.x); acc[j].z += bflo(w.y); acc[j].w += bfhi(w.y); } } }
        float ss = 0.f;
#pragma unroll
        for (int j = 0; j < 4; ++j) { const f32x4 gt = *(const f32x4*)(MODF + (size_t)b * 6 * DM + 5 * DM + 4 * lane + 256 * j);
            xv[j] = xv[j] + gt * acc[j]; ss += (xv[j].x * xv[j].x + xv[j].y * xv[j].y) + (xv[j].z * xv[j].z + xv[j].w * xv[j].w); }
        const float rstd = 1.0f / sqrtf(wave_sum(ss) * (1.0f / DM) + EPS_RMS);
#pragma unroll
        for (int j = 0; j < 4; ++j) { const f32x4 gf = *(const f32x4*)(F.g_final + 4 * lane + 256 * j); ((GAS f32x4*)(dst_base + (size_t)m * DM) + lane)[64 * j] = xv[j] * rstd * gf; }
    }
}

struct Args { const float* in[17]; float* out; unsigned char* ws; int ph_lo, ph_hi; };
__global__ void __launch_bounds__(NWAVES * 64, 2) dit_fwd(Args args) {
    extern __shared__ __attribute__((aligned(16))) unsigned char lds[];
    Frame F;
    F.lds = (LAS unsigned char*)lds;
    F.MISC = (volatile LAS unsigned*)(F.lds + MISC_OFF);
    F.wave = __builtin_amdgcn_readfirstlane((int)threadIdx.x >> 6);
    F.G = gridDim.x; { const int bx = blockIdx.x; F.vcu = (F.G % 8 == 0) ? (bx % 8) * (F.G / 8) + bx / 8 : bx; }
    F.ws = args.ws; F.out = args.out; F.ctl = (gu32*)(args.ws + WS_CTL);
    F.x = args.in[0]; F.c = args.in[1]; F.ctx = args.in[2]; F.c_ctx = args.in[3]; F.w_ada = args.in[4]; F.b_ada = args.in[5]; F.g_mix = args.in[6]; F.w_in = args.in[7];
    F.conv_w = args.in[8]; F.sink = args.in[9]; F.w_out = args.in[10]; F.g_ffn = args.in[11]; F.w_router = args.in[12]; F.w_gate = args.in[13]; F.w_up = args.in[14];
    F.w_down = args.in[15]; F.g_final = args.in[16];
    for (int u = ftid(F); u < (LDS_BYTES - LDSCTL_OFF) / 4; u += NWAVES * 64) ((LAS unsigned*)(F.lds + LDSCTL_OFF))[u] = 0u;
    __syncthreads();
    XcdBarrier bar; bar.bar = (unsigned*)(F.ctl + CW_BAR); bar.x = 0; bar.st = nullptr; bar.w = F.wave;
    if (N_LAUNCHES == 1) bar = xcd_barrier_post((unsigned*)(F.ctl + CW_BAR), F.MISC + 8, F.wave);
    const int lo = args.ph_lo, hi = args.ph_hi;
#ifdef DBG_ONLY
#define IN(k) ((k) == DBG_ONLY && lo <= (k) && (k) < hi)
#else
#define IN(k) (lo <= (k) && (k) < hi)
#endif
#define SEAM(k) do { if (IN(k) && IN((k) + 1)) xcd_barrier(bar); } while (0)
#ifdef DBG_DUP
#define REP(k) for (int rep_ = 0; rep_ < ((k) == DBG_DUP ? 2 : 1); ++rep_)
#define REPBAR(k) do { if ((k) == DBG_DUP && rep_ == 0 && N_LAUNCHES == 1) xcd_barrier(bar); } while (0)
#else
#define REP(k)
#define REPBAR(k) do { } while (0)
#endif

    if (IN(0)) { REP(0) { p0_prologue(F); REPBAR(0); } SEAM(0); }
    if (IN(1)) { REP(1) { p1_norm(F); REPBAR(1); } SEAM(1); }
    if (IN(2)) {
        pg8::Gemm g{(const pg8::bf16_t*)(F.ws + WS_XN), (const pg8::bf16_t*)(F.ws + WS_WIN), MALL, INW, DM};
        pg8::InProjOrder S{F.G, (int)blockIdx.x};
        const float* cosT = (const float*)(F.ws + WS_ROPE);
        pg8::EpiInProj E{(pg8::bf16_t*)(F.ws + WS_Q), (pg8::bf16_t*)(F.ws + WS_K), (pg8::bf16_t*)(F.ws + WS_VT), (pg8::bf16_t*)(F.ws + WS_BG), cosT, cosT + 128 * 16};
        static_assert(WS_CG == WS_BG + (size_t)MTOK * CONVW * 2 && WS_HV == WS_CG + (size_t)MTOK * CONVW * 2, "bg | cg | hv contiguous");
        REP(2) { pg8::gemm_phase<pg8::EpiInProj, pg8::InProjOrder, PG8_ALIGN, PG8_SP2>(F.lds + RING_OFF, g, S, E, F.wave); REPBAR(2); }
        SEAM(2);
    }
    if (IN(3)) { REP(3) { p3_attn_conv(F); REPBAR(3); } SEAM(3); }
    if (IN(4)) {
        pg8::Gemm g{(const pg8::bf16_t*)(F.ws + WS_MIX), (const pg8::bf16_t*)(F.ws + WS_WO), MTOK, DM, DM};
        pg8::StaticOrder S; S.init(MTOK, DM, F.G, (int)blockIdx.x);
        pg8::EpiOutProj E{F.x, F.out, (const float*)(F.ws + WS_MODF)};
        REP(4) { pg8::gemm_phase<pg8::EpiOutProj, pg8::StaticOrder, PG8_ALIGN, PG8_SP2>(F.lds + RING_OFF, g, S, E, F.wave); REPBAR(4); }
        SEAM(4);
    }
    if (IN(5)) { REP(5) { p5_norm_router(F); REPBAR(5); } SEAM(5); }
    if (IN(6)) { REP(6) { for (int task = F.vcu; task < BATCH * NEXP * 8; task += F.G) p6_topk_task(F, task); REPBAR(6); } SEAM(6); }
    if (IN(7)) {
        pg8::Gemm g{(const pg8::bf16_t*)(F.ws + WS_H2), (const pg8::bf16_t*)(F.ws + WS_WGU), NEXP * 2 * CAP, NEXP * 2 * DEXP, DM};
        pg8::MoeOrder<8> S{F.G, (int)blockIdx.x, (const int*)(F.ws + WS_ROWIDX)};
        pg8::EpiGateUp E{(pg8::bf16_t*)(F.ws + WS_ACT)};
        REP(7) { pg8::gemm_phase<pg8::EpiGateUp, pg8::MoeOrder<8>, PG8_ALIGN, PG8_SP2, true>(F.lds + RING_OFF, g, S, E, F.wave); REPBAR(7); }
        SEAM(7);
    }
    if (IN(8)) {
        pg8::Gemm g{(const pg8::bf16_t*)(F.ws + WS_ACT), (const pg8::bf16_t*)(F.ws + WS_WD), NEXP * 2 * CAP, NEXP * DM, DEXP};
        pg8::MoeOrder<4> S{F.G, (int)blockIdx.x, nullptr};
        pg8::EpiDown E{(pg8::bf16_t*)(F.ws + WS_Y), (const float*)(F.ws + WS_GSEL)};
        REP(8) { pg8::gemm_phase<pg8::EpiDown, pg8::MoeOrder<4>, PG8_ALIGN, PG8_SP2>(F.lds + RING_OFF, g, S, E, F.wave); REPBAR(8); }
        SEAM(8);
    }
#if defined(DBG_DUP) && DBG_DUP == 9
    if (IN(9)) { p9_final(F, (float*)(F.ws + WS_WGU)); xcd_barrier(bar); p9_final(F, F.out); }
#elif defined(DBG_DUP) && DBG_DUP == 10
    if (IN(9)) { for (int i = 0; i < 8; ++i) xcd_barrier(bar); p9_final(F, F.out); }
#else
    if (IN(9)) { p9_final(F, F.out); }
#endif
#undef IN
#undef SEAM
}

extern "C" void kernel_launch(void* const* d_in, const int* in_sizes, int n_in, void* d_out, int out_size, void* d_ws, size_t ws_size, hipStream_t stream) {
    static int grid = 0;
    if (grid == 0) {
        if (n_in != 17 || in_sizes[0] != MTOK * DM || out_size != MTOK * DM || ws_size < WS_END) { fprintf(stderr, "kernel_launch: unexpected shapes (n_in %d, in0 %d, out %d, ws %zu); nothing launched\n", n_in, n_in > 0 ? in_sizes[0] : -1, out_size, ws_size); grid = -1; return; }
        int dev = 0, cus = 0, per_cu = 0;
        if (hipGetDevice(&dev) != hipSuccess || hipDeviceGetAttribute(&cus, hipDeviceAttributeMultiprocessorCount, dev) != hipSuccess) { fprintf(stderr, "kernel_launch: device query failed\n"); grid = -1; return; }
        if (hipFuncSetAttribute((const void*)dit_fwd, hipFuncAttributeMaxDynamicSharedMemorySize, LDS_BYTES) != hipSuccess) { fprintf(stderr, "kernel_launch: hipFuncSetAttribute failed\n"); grid = -1; return; }
        if (hipOccupancyMaxActiveBlocksPerMultiprocessor(&per_cu, (const void*)dit_fwd, NWAVES * 64, LDS_BYTES) != hipSuccess || per_cu < 1) { fprintf(stderr, "kernel_launch: occupancy query reports %d workgroups per CU\n", per_cu); per_cu = 1; }
        (void)hipGetLastError();
        grid = cus;
    }
    if (grid < 0) return;
    (void)hipMemsetAsync((char*)d_ws + WS_CTL, 0, CTL_ZERO_BYTES, stream);
    Args a{};
    for (int i = 0; i < 17; ++i) a.in[i] = (const float*)d_in[i];
    a.out = (float*)d_out; a.ws = (unsigned char*)d_ws;
    if (N_LAUNCHES == 1) { a.ph_lo = 0; a.ph_hi = NPH; hipLaunchKernelGGL(dit_fwd, dim3(grid), dim3(NWAVES * 64), LDS_BYTES, stream, a); }
    else for (int li = 0; li < NPH; ++li) { a.ph_lo = li; a.ph_hi = li + 1; hipLaunchKernelGGL(dit_fwd, dim3(grid), dim3(NWAVES * 64), LDS_BYTES, stream, a); }
}
```

```cpp
#include <hip/hip_runtime.h>
#include <cstdio>
#include <cstdint>
namespace pg8 {
#define PG8_LAS __attribute__((address_space(3)))
typedef unsigned short bf16_t;
typedef short bf16x8 __attribute__((ext_vector_type(8)));
typedef float f32x4 __attribute__((ext_vector_type(4)));
typedef unsigned u32x4 __attribute__((ext_vector_type(4)));
constexpr int BM = 256, BK = 64, HALF = 128, HTB = HALF * BK * 2  , STAGE_BYTES = 8 * HTB, NXCD = 8, WGM = 8;

__host__ __device__ __forceinline__ int lds_byte(int r, int c) { const int st = (r >> 4) * 2 + (c >> 5), rr = r & 15, cc = c & 31, ob = rr * 64 + cc * 2; return st * 1024 + (ob ^ (((ob >> 9) & 1) << 5)); }
__host__ __device__ __forceinline__ void stage_rc(int b, int& R, int& C) { const int st = b / 1024, sb = b % 1024, swz = sb ^ (((sb >> 9) & 1) << 5); R = (st >> 1) * 16 + swz / 64; C = (st & 1) * 32 + (swz % 64) / 2; }
__host__ __device__ __forceinline__ int perm32(int rho) { const int n = rho >> 4, i = rho & 15; return 8 * (i >> 2) + 4 * n + (i & 3); }

struct Unit { int pm, pn; };
struct Gemm { const bf16_t* A; const bf16_t* Bt; int M, N, K; };

struct StaticOrder {
    int nM, nN, nwg, G, c;
    __host__ __device__ void init(int M, int N, int G_, int c_) { nM = M / BM; nN = N / BM; nwg = nM * nN; G = G_; c = c_; }
    __host__ __device__ bool next(int i, Unit& u) const {
        const long L = (long)i * G + c; if (L >= nwg) return false;
        int wgid = (int)L; { const int q = nwg / NXCD, r = nwg % NXCD, xcd = wgid % NXCD, off = wgid / NXCD; wgid = (xcd < r ? xcd * (q + 1) : r * (q + 1) + (xcd - r) * q) + off; }
        const int nig = WGM * nN, gid = wgid / nig, fm = gid * WGM, gsz = (nM - fm) < WGM ? (nM - fm) : WGM;
        u.pm = fm + ((wgid % nig) % gsz); u.pn = (wgid % nig) / gsz; return true;
    }
    __device__ __forceinline__ void a_ready(const Unit&) const {}
    __device__ __forceinline__ void done(const Unit&) const {}
};

__device__ __forceinline__ unsigned cvt_pk_bf16(float lo, float hi) { unsigned r; asm volatile("v_cvt_pk_bf16_f32 %0, %1, %2" : "=v"(r) : "v"(lo), "v"(hi)); return r; }
__device__ __forceinline__ int pg8_lane() { int l; asm volatile("v_mbcnt_lo_u32_b32 %0, -1, 0\n\tv_mbcnt_hi_u32_b32 %0, -1, %0" : "=v"(l)); return l; }
template <class Epi, class Sched, bool ALIGN_EPI = false, bool SP2 = false, bool GATHER = false>
__device__ __forceinline__ void gemm_phase(PG8_LAS unsigned char* lds, const Gemm g, const Sched& S, const Epi& E, const int wave_id) {
    const int wid = wave_id, lane = pg8_lane(), tid = wid * 64 + lane, wr = wid >> 2, wc = wid & 3, fr = lane & 15, fq = lane >> 4;
    const int K = g.K, nt = K / BK;
    unsigned voffA[2], voffB[2];
#pragma unroll
    for (int i = 0; i < 2; ++i) { int R, C; stage_rc(tid * 16 + i * 8192, R, C); const int Rb = Epi::PERM ? ((R & ~31) + perm32(R & 31)) : R;
        voffA[i] = (unsigned)(R * K + C) * 2u; voffB[i] = (unsigned)(Rb * K + C) * 2u; }
    static_assert(!GATHER || SP2, "GATHER is implemented for the SP2 loop");
    int gR[2]; unsigned gC[2]; unsigned va[2][2], vn[2][2];
#pragma unroll
    for (int i = 0; i < 2; ++i) { int R, C; stage_rc(tid * 16 + i * 8192, R, C); gR[i] = R; gC[i] = (unsigned)C * 2u; va[0][i] = va[1][i] = vn[0][i] = vn[1][i] = 0u; }
#define PG8_GROWS(dst, pm_) do { if constexpr (GATHER) { _Pragma("unroll") for (int h_ = 0; h_ < 2; ++h_) _Pragma("unroll") for (int i_ = 0; i_ < 2; ++i_) \
        dst[h_][i_] = (unsigned)S.rowidx[(pm_) * BM + h_ * HALF + gR[i_]] * (unsigned)(K * 2) + gC[i_]; } } while (0)
#define PG8_STAGE_A(bufoff, gbase, H, NX) do { if constexpr (GATHER) { _Pragma("unroll") for (int _i = 0; _i < 2; ++_i) \
        __builtin_amdgcn_global_load_lds((const unsigned*)((const char*)(gbase) + ((NX) ? vn[H][_i] : va[H][_i])), (PG8_LAS unsigned*)(lds + (bufoff) + ldsw + _i * 8192), 16, 0, 0); } \
    else { PG8_STAGE(bufoff, (gbase) + (H) * hstep, voffA); } } while (0)
    const size_t kstep = (size_t)(BK * 2);
    const size_t hstep = (size_t)HALF * K * 2;
    const size_t tstep = 2 * hstep;
    const unsigned ldsw = (unsigned)wid * 1024u;
    const int aoff = lds_byte(wr * 64 + fr, fq * 8), boff = lds_byte(wc * 32 + fr, fq * 8);
#define PG8_SA(b, h) (((b) * 2 + (h)) * HTB)
#define PG8_SB(b, h) ((4 + (b) * 2 + (h)) * HTB)
#define PG8_STAGE(bufoff, gbase, voff) do { _Pragma("unroll") for (int _i = 0; _i < 2; ++_i) \
        __builtin_amdgcn_global_load_lds((const unsigned*)((const char*)(gbase) + (voff)[_i]), (PG8_LAS unsigned*)(lds + (bufoff) + ldsw + _i * 8192), 16, 0, 0); } while (0)
#define PG8_LDA(dst, b, h) do { _Pragma("unroll") for (int m = 0; m < 4; ++m) _Pragma("unroll") for (int k = 0; k < 2; ++k) dst[m][k] = *(const PG8_LAS bf16x8*)(lds + PG8_SA(b, h) + aoff + m * 2048 + k * 1024); } while (0)
#define PG8_LDB(dst, b, h) do { _Pragma("unroll") for (int n = 0; n < 2; ++n) _Pragma("unroll") for (int k = 0; k < 2; ++k) dst[n][k] = *(const PG8_LAS bf16x8*)(lds + PG8_SB(b, h) + boff + n * 2048 + k * 1024); } while (0)
#define PG8_MMA(ai, bj, At, Bt) do { __builtin_amdgcn_s_setprio(1); _Pragma("unroll") for (int m = 0; m < 4; ++m) _Pragma("unroll") for (int n = 0; n < 2; ++n) _Pragma("unroll") for (int k = 0; k < 2; ++k) \
        acc[ai][bj][m][n] = __builtin_amdgcn_mfma_f32_16x16x32_bf16(Bt[n][k], At[m][k], acc[ai][bj][m][n], 0, 0, 0); __builtin_amdgcn_s_setprio(0); } while (0)
#define PG8_WAIT_V(n) asm volatile("s_waitcnt vmcnt(" #n ")" ::: "memory")
#define PG8_WAIT_L(n) asm volatile("s_waitcnt lgkmcnt(" #n ")" ::: "memory")
#define PG8_BAR __builtin_amdgcn_s_barrier()
#define PG8_SCHED __builtin_amdgcn_sched_barrier(0)
    Unit cur, nxt; int ui = 0;
    if (!S.next(0, cur)) return;
    f32x4 acc[2][2][4][2];
#pragma unroll
    for (int a = 0; a < 2; ++a)
#pragma unroll
        for (int b = 0; b < 2; ++b)
#pragma unroll
            for (int m = 0; m < 4; ++m)
#pragma unroll
                for (int n = 0; n < 2; ++n) acc[a][b][m][n] = (f32x4){0.f, 0.f, 0.f, 0.f};
    bf16x8 At[4][2], B0[2][2], B1[2][2];
    const char* cA = (const char*)g.A + (GATHER ? (size_t)0 : (size_t)cur.pm * tstep); PG8_GROWS(va, cur.pm); const char* cB = (const char*)g.Bt + (size_t)cur.pn * tstep;
    S.a_ready(cur);
    if constexpr (SP2) {
        PG8_STAGE(PG8_SB(0, 0), cB, voffB); PG8_STAGE(PG8_SB(0, 1), cB + hstep, voffB); PG8_STAGE_A(PG8_SA(0, 0), cA, 0, false); PG8_STAGE_A(PG8_SA(0, 1), cA, 1, false);
        if (wr == 1) PG8_BAR;
        PG8_WAIT_V(2); PG8_BAR;
        PG8_STAGE(PG8_SB(1, 0), cB + kstep, voffB); PG8_STAGE_A(PG8_SA(1, 0), cA + kstep, 0, false); PG8_STAGE(PG8_SB(1, 1), cB + hstep + kstep, voffB);
        PG8_WAIT_V(6); PG8_BAR;
    } else {
        PG8_STAGE(PG8_SB(0, 0), cB, voffB); PG8_STAGE(PG8_SA(0, 0), cA, voffA); PG8_STAGE(PG8_SB(0, 1), cB + hstep, voffB); PG8_STAGE(PG8_SA(0, 1), cA + hstep, voffA);
        if (wr == 1) PG8_BAR;
        PG8_WAIT_V(4); PG8_BAR;
        PG8_STAGE(PG8_SB(1, 0), cB + kstep, voffB); PG8_STAGE(PG8_SA(1, 0), cA + kstep, voffA); PG8_STAGE(PG8_SB(1, 1), cB + hstep + kstep, voffB);
        PG8_WAIT_V(6); PG8_BAR;
    }
    for (;;) {
        const bool has_next = S.next(ui + 1, nxt);
        const char* nA = (has_next && !GATHER) ? (const char*)g.A + (size_t)nxt.pm * tstep : cA;
        if constexpr (GATHER) { if (has_next) { PG8_GROWS(vn, nxt.pm); } else { _Pragma("unroll") for (int h_ = 0; h_ < 2; ++h_) _Pragma("unroll") for (int i_ = 0; i_ < 2; ++i_) vn[h_][i_] = va[h_][i_]; } } const char* nB = has_next ? (const char*)g.Bt + (size_t)nxt.pn * tstep : cB;
        for (int t = 0; t < nt; t += 2) {
            const bool last = (t == nt - 2);
            const char* a1 = cA + (size_t)(t + 1) * kstep;
            const char* a2 = last ? nA : cA + (size_t)(t + 2) * kstep; const char* b2 = last ? nB : cB + (size_t)(t + 2) * kstep;
            const char* a3 = a2 + kstep; const char* b3 = b2 + kstep;
            if (last && has_next) S.a_ready(nxt);
            if constexpr (SP2) {
            PG8_LDB(B0, 0, 0); PG8_LDB(B1, 0, 1); PG8_SCHED; PG8_LDA(At, 0, 0); PG8_STAGE_A(PG8_SA(1, 1), a1, 1, false);
            PG8_WAIT_V(8); PG8_WAIT_L(0); PG8_BAR; PG8_MMA(0, 0, At, B0); PG8_MMA(0, 1, At, B1); PG8_BAR; PG8_SCHED;
            PG8_LDA(At, 0, 1); PG8_STAGE(PG8_SB(0, 0), b2, voffB); PG8_STAGE(PG8_SB(0, 1), b2 + hstep, voffB); PG8_STAGE_A(PG8_SA(0, 0), a2, 0, last);
            PG8_WAIT_V(8); PG8_WAIT_L(0); PG8_BAR; PG8_MMA(1, 0, At, B0); PG8_MMA(1, 1, At, B1); PG8_BAR; PG8_SCHED;
            PG8_LDB(B0, 1, 0); PG8_LDB(B1, 1, 1); PG8_SCHED; PG8_LDA(At, 1, 0); PG8_STAGE_A(PG8_SA(0, 1), a2, 1, last);
            PG8_WAIT_V(8); PG8_WAIT_L(0); PG8_BAR; PG8_MMA(0, 0, At, B0); PG8_MMA(0, 1, At, B1); PG8_BAR; PG8_SCHED;
            PG8_LDA(At, 1, 1); PG8_STAGE(PG8_SB(1, 0), b3, voffB); PG8_STAGE(PG8_SB(1, 1), b3 + hstep, voffB); PG8_STAGE_A(PG8_SA(1, 0), a3, 0, last);
            PG8_WAIT_V(8); PG8_WAIT_L(0); PG8_BAR; PG8_MMA(1, 0, At, B0); PG8_MMA(1, 1, At, B1); PG8_BAR; PG8_SCHED;
            } else {
            PG8_LDB(B0, 0, 0); PG8_SCHED; PG8_LDA(At, 0, 0); PG8_STAGE(PG8_SA(1, 1), a1 + hstep, voffA);
            PG8_WAIT_L(8); PG8_BAR; PG8_WAIT_L(0); PG8_MMA(0, 0, At, B0); PG8_BAR; PG8_SCHED;
            PG8_LDB(B1, 0, 1); PG8_STAGE(PG8_SB(0, 0), b2, voffB);
            PG8_BAR; PG8_WAIT_L(0); PG8_MMA(0, 1, At, B1); PG8_BAR;
            PG8_LDA(At, 0, 1); PG8_STAGE(PG8_SA(0, 0), a2, voffA);
            PG8_BAR; PG8_WAIT_L(0); PG8_MMA(1, 0, At, B0); PG8_BAR; PG8_SCHED;
            PG8_STAGE(PG8_SB(0, 1), b2 + hstep, voffB);
            PG8_WAIT_V(6); PG8_BAR; PG8_MMA(1, 1, At, B1); PG8_BAR;
            PG8_LDB(B0, 1, 0); PG8_SCHED; PG8_LDA(At, 1, 0); PG8_STAGE(PG8_SA(0, 1), a2 + hstep, voffA);
            PG8_WAIT_L(8); PG8_BAR; PG8_WAIT_L(0); PG8_MMA(0, 0, At, B0); PG8_BAR; PG8_SCHED;
            PG8_LDB(B1, 1, 1); PG8_STAGE(PG8_SB(1, 0), b3, voffB);
            PG8_BAR; PG8_WAIT_L(0); PG8_MMA(0, 1, At, B1); PG8_BAR;
            PG8_LDA(At, 1, 1); PG8_STAGE(PG8_SA(1, 0), a3, voffA);
            PG8_BAR; PG8_WAIT_L(0); PG8_MMA(1, 0, At, B0); PG8_BAR; PG8_SCHED;
            PG8_STAGE(PG8_SB(1, 1), b3 + hstep, voffB);
            PG8_WAIT_V(6); PG8_BAR; PG8_MMA(1, 1, At, B1); PG8_BAR;
            }
        }
        if constexpr (ALIGN_EPI) { if (wr == 0) PG8_BAR; }
        if constexpr (!Epi::AFTER_DRAIN) { E(acc, cur, wr, wc, fr, fq); S.done(cur); }
        if (!has_next) break;
#pragma unroll
        for (int a = 0; a < 2; ++a)
#pragma unroll
            for (int b = 0; b < 2; ++b)
#pragma unroll
                for (int m = 0; m < 4; ++m)
#pragma unroll
                    for (int n = 0; n < 2; ++n) acc[a][b][m][n] = (f32x4){0.f, 0.f, 0.f, 0.f};
        cur = nxt; cA = nA; cB = nB; ++ui;
        if constexpr (GATHER) { _Pragma("unroll") for (int h_ = 0; h_ < 2; ++h_) _Pragma("unroll") for (int i_ = 0; i_ < 2; ++i_) va[h_][i_] = vn[h_][i_]; }
        if constexpr (ALIGN_EPI) { if (wr == 1) PG8_BAR; }
    }
    PG8_WAIT_V(0);
    if constexpr (!ALIGN_EPI) { if (wr == 0) PG8_BAR; }
    PG8_BAR;
    if constexpr (Epi::AFTER_DRAIN) { E.fused(acc, cur, wr, wc, fr, fq, lds, wid, lane); S.done(cur); }
#undef PG8_SA
#undef PG8_SB
#undef PG8_STAGE
#undef PG8_STAGE_A
#undef PG8_GROWS
#undef PG8_LDA
#undef PG8_LDB
#undef PG8_MMA
#undef PG8_WAIT_V
#undef PG8_WAIT_L
#undef PG8_BAR
#undef PG8_SCHED
}
}

constexpr int BATCH = 2, SEQ = 8192, DM = 1024, MTOK = BATCH * SEQ, CTXL = 256, MCTX = BATCH * CTXL, MALL = MTOK + MCTX;
constexpr int NHEAD = 8, NKVH = 2, HDIM = 64, ATTW = 512, KVW = 128, CONVW = 512, INW = 2304;
constexpr int NEXP = 16, CAP = 1024, DEXP = 1024;
constexpr int KVROWS = CTXL + SEQ;
constexpr float EPS_RMS = 1e-6f;
constexpr float QSCALE = 0.125f * 1.4426950408889634f;

namespace pg8 {
typedef unsigned u32x2 __attribute__((ext_vector_type(2)));
__device__ __forceinline__ float bf2f(unsigned short h) { return __uint_as_float((unsigned)h << 16); }

struct InProjOrder {
    int G, c;
    __device__ bool next(int i, Unit& u) const {
        const int L = i * G + c; constexpr int nM = 64, nN = 9, nwg = nM * nN;
        if (L >= nwg + 2) return false;
        if (L >= nwg) { u.pm = 64 + (L - nwg); u.pn = 2; return true; }
        int wgid = L; { const int q = nwg / NXCD, r = nwg % NXCD, xcd = wgid % NXCD, off = wgid / NXCD; wgid = (xcd < r ? xcd * (q + 1) : r * (q + 1) + (xcd - r) * q) + off; }
        const int nig = WGM * nN, gid = wgid / nig, fm = gid * WGM, gsz = (nM - fm) < WGM ? (nM - fm) : WGM;
        u.pm = fm + ((wgid % nig) % gsz); u.pn = (wgid % nig) / gsz; return true;
    }
    __device__ __forceinline__ void a_ready(const Unit&) const {}
    __device__ __forceinline__ void done(const Unit&) const {}
};
template <int NPE> struct MoeOrder {
    int G, c; const int* rowidx;
    __device__ bool next(int i, Unit& u) const {
        const int L = i * G + c; constexpr int U = NEXP * 8 * NPE;
        if (L >= U) return false;
        const int id = (L % NXCD) * (U / NXCD) + L / NXCD;
        const int e = id / (8 * NPE), sub = id % (8 * NPE);
        u.pm = e * 8 + (sub & 7); u.pn = e * NPE + (sub >> 3); return true;
    }
    __device__ __forceinline__ void a_ready(const Unit&) const {}
    __device__ __forceinline__ void done(const Unit&) const {}
};

struct EpiInProj {
    static constexpr bool PERM = true, AFTER_DRAIN = false;
    bf16_t *Q, *Kb, *Vt, *BG; const float* cosT; const float* sinT;
    __device__ __forceinline__ void operator()(const f32x4 (&acc)[2][2][4][2], const Unit& u, int wr, int wc, int fr, int fq) const {
        const int row0 = u.pm * BM + wr * 64 + fr;
        if (u.pn >= 3) {
            bf16_t* base = BG + (size_t)((u.pn - 3) >> 1) * ((size_t)MTOK * CONVW);
            const int col0 = ((u.pn - 3) & 1) * 256 + wc * 32 + 8 * fq;
#pragma unroll
            for (int ai = 0; ai < 2; ++ai)
#pragma unroll
                for (int m = 0; m < 4; ++m) { bf16_t* rowp = base + (size_t)(row0 + ai * HALF + m * 16) * CONVW + col0;
#pragma unroll
                    for (int bj = 0; bj < 2; ++bj) { const f32x4 v0 = acc[ai][bj][m][0], v1 = acc[ai][bj][m][1];
                        u32x4 w; w.x = cvt_pk_bf16(v0[0], v0[1]); w.y = cvt_pk_bf16(v0[2], v0[3]); w.z = cvt_pk_bf16(v1[0], v1[1]); w.w = cvt_pk_bf16(v1[2], v1[3]);
                        *(u32x4*)(rowp + bj * HALF) = w; } }
        } else if (u.pn < 2) {
            const int dbase = 16 * (wc & 1) + 4 * fq;
#pragma unroll
            for (int ai = 0; ai < 2; ++ai)
#pragma unroll
                for (int m = 0; m < 4; ++m) { const int r = row0 + ai * HALF + m * 16, t = r & (SEQ - 1), pos = (wc & 1) ? (t & 63) : (t >> 6);
                    const f32x4 cs = *(const f32x4*)(cosT + pos * 16 + 4 * fq), sn = *(const f32x4*)(sinT + pos * 16 + 4 * fq);
#pragma unroll
                    for (int bj = 0; bj < 2; ++bj) { const f32x4 x1 = acc[ai][bj][m][0], x2 = acc[ai][bj][m][1];
                        const f32x4 o1 = (x1 * cs - x2 * sn) * QSCALE, o2 = (x1 * sn + x2 * cs) * QSCALE;
                        bf16_t* p = Q + (size_t)r * ATTW + (u.pn * 4 + bj * 2 + (wc >> 1)) * HDIM + dbase;
                        u32x2 a, b; a.x = cvt_pk_bf16(o1[0], o1[1]); a.y = cvt_pk_bf16(o1[2], o1[3]); b.x = cvt_pk_bf16(o2[0], o2[1]); b.y = cvt_pk_bf16(o2[2], o2[3]);
                        *(u32x2*)p = a; *(u32x2*)(p + 32) = b; }
                    asm volatile("" ::: "memory"); }
        } else {
            const bool is_ctx = u.pm >= MTOK / BM; const int dbase = 16 * (wc & 1) + 4 * fq, kvh = wc >> 1;
#pragma unroll
            for (int ai = 0; ai < 2; ++ai)
#pragma unroll
                for (int m = 0; m < 4; ++m) { const int r = row0 + ai * HALF + m * 16; int b, kvrow; f32x4 o1 = acc[ai][0][m][0], o2 = acc[ai][0][m][1];
                    if (!is_ctx) { b = r >> 13; const int t = r & (SEQ - 1), pos = (wc & 1) ? (t & 63) : (t >> 6); kvrow = CTXL + t;
                        const f32x4 cs = *(const f32x4*)(cosT + pos * 16 + 4 * fq), sn = *(const f32x4*)(sinT + pos * 16 + 4 * fq);
                        const f32x4 x1 = o1, x2 = o2; o1 = x1 * cs - x2 * sn; o2 = x1 * sn + x2 * cs; }
                    else { const int rr = r - MTOK; b = rr >> 8; kvrow = rr & (CTXL - 1); }
                    bf16_t* p = Kb + ((size_t)(b * NKVH + kvh) * KVROWS + kvrow) * HDIM + dbase;
                    u32x2 a, c2; a.x = cvt_pk_bf16(o1[0], o1[1]); a.y = cvt_pk_bf16(o1[2], o1[3]); c2.x = cvt_pk_bf16(o2[0], o2[1]); c2.y = cvt_pk_bf16(o2[2], o2[3]);
                    *(u32x2*)p = a; *(u32x2*)(p + 32) = c2;
                    bf16_t* vp = Vt + ((size_t)(b * NKVH + kvh) * HDIM + 32 * (wc & 1) + 8 * fq) * KVROWS + kvrow;
#pragma unroll
                    for (int n = 0; n < 2; ++n) { const f32x4 v = acc[ai][1][m][n]; const unsigned w0 = cvt_pk_bf16(v[0], v[1]), w1 = cvt_pk_bf16(v[2], v[3]);
                        vp[(size_t)(4 * n + 0) * KVROWS] = (bf16_t)(w0 & 0xffffu); vp[(size_t)(4 * n + 1) * KVROWS] = (bf16_t)(w0 >> 16);
                        vp[(size_t)(4 * n + 2) * KVROWS] = (bf16_t)(w1 & 0xffffu); vp[(size_t)(4 * n + 3) * KVROWS] = (bf16_t)(w1 >> 16); }
                    asm volatile("" ::: "memory"); }
        }
    }
};
struct EpiOutProj {
    static constexpr bool PERM = false, AFTER_DRAIN = false;
    const float* x; float* x1; const float* modf;
    __device__ __forceinline__ void operator()(const f32x4 (&acc)[2][2][4][2], const Unit& u, int wr, int wc, int fr, int fq) const {
        const int row0 = u.pm * BM + wr * 64 + fr, col0 = u.pn * BM + wc * 32 + 4 * fq, b = (u.pm * BM) >> 13;
        f32x4 gt[2][2];
#pragma unroll
        for (int bj = 0; bj < 2; ++bj)
#pragma unroll
            for (int n = 0; n < 2; ++n) gt[bj][n] = *(const f32x4*)(modf + (size_t)b * 6 * DM + 2 * DM + col0 + bj * HALF + n * 16);
#pragma unroll
        for (int ai = 0; ai < 2; ++ai)
#pragma unroll
            for (int m = 0; m < 4; ++m) { const size_t off = (size_t)(row0 + ai * HALF + m * 16) * DM + col0;
#pragma unroll
                for (int bj = 0; bj < 2; ++bj)
#pragma unroll
                    for (int n = 0; n < 2; ++n) { const f32x4 xv = *(const f32x4*)(x + off + bj * HALF + n * 16); *(f32x4*)(x1 + off + bj * HALF + n * 16) = xv + gt[bj][n] * acc[ai][bj][m][n]; } }
    }
};
struct EpiGateUp {
    static constexpr bool PERM = true, AFTER_DRAIN = false;
    bf16_t* act;
    __device__ __forceinline__ void operator()(const f32x4 (&acc)[2][2][4][2], const Unit& u, int wr, int wc, int fr, int fq) const {
        const int row0 = u.pm * BM + wr * 64 + fr, col0 = (u.pn & 7) * HALF + wc * 32 + 8 * fq;
#pragma unroll
        for (int ai = 0; ai < 2; ++ai)
#pragma unroll
            for (int m = 0; m < 4; ++m) { float o[8];
#pragma unroll
                for (int n = 0; n < 2; ++n)
#pragma unroll
                    for (int i = 0; i < 4; ++i) { const float g = acc[ai][0][m][n][i], up = acc[ai][1][m][n][i];
                        o[4 * n + i] = g * up * __builtin_amdgcn_rcpf(1.0f + __builtin_amdgcn_exp2f(-1.4426950408889634f * g)); }
                u32x4 w; w.x = cvt_pk_bf16(o[0], o[1]); w.y = cvt_pk_bf16(o[2], o[3]); w.z = cvt_pk_bf16(o[4], o[5]); w.w = cvt_pk_bf16(o[6], o[7]);
                *(u32x4*)(act + (size_t)(row0 + ai * HALF + m * 16) * DEXP + col0) = w; }
    }
};
struct EpiDown {
    static constexpr bool PERM = true, AFTER_DRAIN = false;
    bf16_t* y; const float* gsel;
    __device__ __forceinline__ void operator()(const f32x4 (&acc)[2][2][4][2], const Unit& u, int wr, int wc, int fr, int fq) const {
        const int row0 = u.pm * BM + wr * 64 + fr, col0 = (u.pn & 3) * BM + wc * 32 + 8 * fq;
#pragma unroll
        for (int ai = 0; ai < 2; ++ai)
#pragma unroll
            for (int m = 0; m < 4; ++m) { const int r = row0 + ai * HALF + m * 16; const float g = gsel[r];
#pragma unroll
                for (int bj = 0; bj < 2; ++bj) { const f32x4 v0 = acc[ai][bj][m][0] * g, v1 = acc[ai][bj][m][1] * g;
                    u32x4 w; w.x = cvt_pk_bf16(v0[0], v0[1]); w.y = cvt_pk_bf16(v0[2], v0[3]); w.z = cvt_pk_bf16(v1[0], v1[1]); w.w = cvt_pk_bf16(v1[2], v1[3]);
                    *(u32x4*)(y + (size_t)r * DM + col0 + bj * HALF) = w; } }
    }
};
}
#ifndef PG8_SP2
#define PG8_SP2 true
#endif
#ifndef PG8_ALIGN
#define PG8_ALIGN true
#endif

constexpr int NWAVES = 8;
constexpr int NPH = 10;
#ifndef MK_N_LAUNCHES
#define MK_N_LAUNCHES 1
#endif
constexpr int N_LAUNCHES = MK_N_LAUNCHES;
static_assert(N_LAUNCHES == 1 || N_LAUNCHES == NPH, "MK_N_LAUNCHES is 1 or 10");

constexpr size_t MiB = 1u << 20;
constexpr size_t WS_CTL = 0, CTL_ZERO_BYTES = 64 * 1024;
constexpr size_t WS_MODP = 1 * MiB;
constexpr size_t WS_MODF = 2 * MiB + 512 * 1024;
constexpr size_t WS_ROPE = 2 * MiB + 768 * 1024;
constexpr size_t WS_AFF = 3 * MiB;
constexpr size_t WS_GSEL = 4 * MiB;
constexpr size_t WS_ROWIDX = 4 * MiB + 256 * 1024;
constexpr size_t WS_SEL = 5 * MiB;
constexpr size_t WS_WIN = 6 * MiB, WS_WO = 11 * MiB;
constexpr size_t WS_WGU = 16 * MiB, WS_WD = 80 * MiB;
constexpr size_t WS_XN = 112 * MiB;
constexpr size_t WS_MIX = 112 * MiB;
constexpr size_t WS_H2 = 146 * MiB;
constexpr size_t WS_ACT = 178 * MiB;
constexpr size_t WS_Q = 178 * MiB, WS_K = 194 * MiB, WS_VT = 198 * MiB + 512 * 1024, WS_BG = 203 * MiB, WS_CG = 219 * MiB, WS_HV = 235 * MiB;
constexpr size_t WS_Y = 112 * MiB;
constexpr size_t WS_END = 251 * MiB;
static_assert(WS_K + (size_t)BATCH * NKVH * KVROWS * HDIM * 2 <= WS_VT && WS_VT + (size_t)BATCH * NKVH * KVROWS * HDIM * 2 <= WS_BG, "K / V^T buffers");
static_assert(WS_XN + (size_t)MALL * DM * 2 <= WS_H2 && WS_H2 + (size_t)MTOK * DM * 2 <= WS_Q && WS_ACT + (size_t)NEXP * 2 * CAP * DM * 2 <= WS_END && WS_Y + (size_t)NEXP * 2 * CAP * DM * 2 <= WS_Q, "d_ws map");
constexpr int CW_BAR = 1024;
constexpr int RING_OFF = 0, RING_BYTES = 131072;
constexpr int LDSCTL_OFF = RING_BYTES, MISC_OFF = LDSCTL_OFF + 320;
constexpr int LDS_BYTES = 147456;

#define GAS __attribute__((address_space(1)))
#define LAS __attribute__((address_space(3)))
typedef unsigned short bf16;
typedef unsigned v4u __attribute__((ext_vector_type(4)));
typedef unsigned v2u __attribute__((ext_vector_type(2)));
typedef float f32x4 __attribute__((ext_vector_type(4)));
typedef float f32x16 __attribute__((ext_vector_type(16)));
typedef short bf16x8 __attribute__((ext_vector_type(8)));
typedef GAS unsigned gu32;
#define RLX_AGENT __ATOMIC_RELAXED, __HIP_MEMORY_SCOPE_AGENT
#define LDS_WAIT() asm volatile("s_waitcnt lgkmcnt(0)" ::: "memory")
#define VM_WAIT() asm volatile("s_waitcnt vmcnt(0)" ::: "memory")
__device__ __forceinline__ unsigned f2bf(float f) { unsigned u = __builtin_bit_cast(unsigned, f); return (u + 0x7fffu + ((u >> 16) & 1u)) >> 16; }
__device__ __forceinline__ unsigned pk2(float lo, float hi) { return f2bf(lo) | (f2bf(hi) << 16); }
__device__ __forceinline__ float bflo(unsigned w) { return __uint_as_float(w << 16); }
__device__ __forceinline__ float bfhi(unsigned w) { return __uint_as_float(w & 0xffff0000u); }
#define XB_TMO      128
#define XB_XCNT(j)  (256  + 64 * (j))
#define XB_XSUB(j)  (1280 + 64 * (j))
#define XB_XGEN(j)  (2304 + 64 * (j))
#define XB_TOP      3328
#define XB_TOPGEN   3392
#define XCD_BAR_WORDS 3456
#define XB_SPIN_CAP (1u << 18)

__device__ __forceinline__ unsigned xb_ld(unsigned* p)              { return __hip_atomic_load(p, __ATOMIC_RELAXED, __HIP_MEMORY_SCOPE_AGENT); }
__device__ __forceinline__ unsigned xb_add(unsigned* p, unsigned v) { return __hip_atomic_fetch_add(p, v, __ATOMIC_RELAXED, __HIP_MEMORY_SCOPE_AGENT); }
__device__ __forceinline__ unsigned xb_xcc_id() { return (unsigned)__builtin_amdgcn_s_getreg((3 << 11) | 20) & 0xFu; }
#define XB_SPIN(cond, bar) do { unsigned _sp = 0; while (cond) { __builtin_amdgcn_s_sleep(1); \
    if ((++_sp & 255u) == 0u) { if (xb_ld(&(bar)[XB_TMO])) break; if (_sp > XB_SPIN_CAP) { atomicAdd(&(bar)[XB_TMO], 1u); break; } } } } while (0)

struct XcdBarrier {
    unsigned* bar; unsigned x;
    volatile LAS unsigned* st;
    int w;
};

__device__ __forceinline__ int xb_lane() { int l; asm volatile("v_mbcnt_lo_u32_b32 %0, -1, 0\n\tv_mbcnt_hi_u32_b32 %0, -1, %0" : "=v"(l)); return l; }
#define MY_TID0() (b.w == 0 && xb_lane() == 0)
__device__ __forceinline__ XcdBarrier xcd_barrier_post(unsigned* bar, volatile LAS unsigned* st, int w) {
    XcdBarrier b; b.bar = bar; b.x = xb_xcc_id(); b.st = st; b.w = w;
    if (MY_TID0()) (void)xb_add(&bar[XB_XCNT(b.x)], 1u);
    return b;
}
__device__ __forceinline__ void xcd_barrier_complete(unsigned* bar, unsigned x, unsigned& nloc, unsigned& nx) {
    const unsigned G = gridDim.x * gridDim.y * gridDim.z;
    unsigned sum, cnt, mine, sp = 0u;
    for (;;) {
        sum = 0u; cnt = 0u; mine = 0u;
#pragma unroll
        for (unsigned j = 0; j < 16; ++j) { const unsigned c = xb_ld(&bar[XB_XCNT(j)]); sum += c; cnt += (c > 0u) ? 1u : 0u; mine = (j == x) ? c : mine; }
        if (sum == G) break;
        __builtin_amdgcn_s_sleep(1);
        if ((++sp & 255u) == 0u) { if (xb_ld(&bar[XB_TMO])) break; if (sp > XB_SPIN_CAP) { atomicAdd(&bar[XB_TMO], 1u); break; } }
    }
    nloc = mine > 0u ? mine : 1u; nx = cnt > 0u ? cnt : 1u;
}

__device__ __forceinline__ void xcd_barrier(const XcdBarrier& b) {
    asm volatile("s_waitcnt vmcnt(0)" ::: "memory");
    __syncthreads();
    if (MY_TID0()) {
        unsigned* bar = b.bar;
        __builtin_amdgcn_s_waitcnt(0);
        unsigned nloc = b.st[0], nx = b.st[1];
        if (nloc == 0u) { xcd_barrier_complete(bar, b.x, nloc, nx); b.st[0] = nloc; b.st[1] = nx; }
        const unsigned old = xb_add(&bar[XB_XSUB(b.x)], 1u);
        const unsigned gen = old / nloc;
        if (old + 1u == (gen + 1u) * nloc) {
            __builtin_amdgcn_fence(__ATOMIC_RELEASE, "agent");
            asm volatile("s_waitcnt vmcnt(0)" ::: "memory");
            const unsigned og = xb_add(&bar[XB_TOP], 1u);
            const unsigned tg = og / nx;
            if (og + 1u == (tg + 1u) * nx) xb_add(&bar[XB_TOPGEN], 1u);
            else XB_SPIN(xb_ld(&bar[XB_TOPGEN]) == tg, bar);
            __builtin_amdgcn_fence(__ATOMIC_ACQUIRE, "agent");
            xb_add(&bar[XB_XGEN(b.x)], 1u);
            asm volatile("s_waitcnt vmcnt(0)" ::: "memory");
        } else {
            XB_SPIN(xb_ld(&bar[XB_XGEN(b.x)]) == gen, bar);
            __builtin_amdgcn_fence(__ATOMIC_ACQUIRE, "agent");
            asm volatile("s_waitcnt vmcnt(0)" ::: "memory");
        }
    }
    __syncthreads();
}

__device__ __forceinline__ int lane_id() { int l; asm volatile("v_mbcnt_lo_u32_b32 %0, -1, 0\n\tv_mbcnt_hi_u32_b32 %0, -1, %0" : "=v"(l)); return l; }
struct Frame {
    LAS unsigned char* lds;
    volatile LAS unsigned* MISC;
    gu32* ctl;
    int wave, vcu, G;
    const float *x, *c, *ctx, *c_ctx, *w_ada, *b_ada, *g_mix, *w_in, *conv_w, *sink, *w_out, *g_ffn, *w_router, *w_gate, *w_up, *w_down, *g_final;
    float* out; unsigned char* ws;
};
__device__ __forceinline__ int ftid(const Frame& F) { return F.wave * 64 + lane_id(); }
__device__ __forceinline__ float wave_sum(float v) {
#pragma unroll
    for (int o = 1; o < 64; o <<= 1) v += __shfl_xor(v, o);
    return v;
}
typedef float f32x2_t __attribute__((ext_vector_type(2))); typedef __bf16 bf16x2_t __attribute__((ext_vector_type(2)));
__device__ __forceinline__ unsigned cvtpk(float lo, float hi) { f32x2_t v = {lo, hi}; bf16x2_t b = __builtin_convertvector(v, bf16x2_t); return __builtin_bit_cast(unsigned, b); }

template <int MODE> __device__ __forceinline__ int wt_row(int n, int row_off) {
    if (MODE == 0) return row_off + n;
    if (MODE == 1) { if (n >= ATTW + KVW) return n; const int d = n & 63; return (n & ~63) + 8 * ((d & 31) >> 2) + 4 * (d >> 5) + (d & 3); }
    return row_off + (n >> 7) * 256 + (n & 127) + (MODE == 3 ? 128 : 0);
}
template <int MODE> __device__ __forceinline__ void p0_transpose_item(const float* W, int K, int N, bf16* WT, int row_off, LAS float* scr, int item, int lane) {
    const int nblk = N / 32, kb = item / nblk, nb = item % nblk, k0 = 64 * kb, n0 = 32 * nb;
#pragma unroll 8
    for (int i = 0; i < 32; ++i) { const int kk = 2 * i + (lane >> 5); scr[kk * 33 + (lane & 31)] = W[(size_t)(k0 + kk) * N + n0 + (lane & 31)]; }
    LDS_WAIT(); asm volatile("" ::: "memory");
    const int c = lane & 7;
#pragma unroll
    for (int j = 0; j < 4; ++j) { const int n = (lane >> 3) + 8 * j; const LAS float* s = scr + (8 * c) * 33 + n;
        v4u o; o.x = pk2(s[0 * 33], s[1 * 33]); o.y = pk2(s[2 * 33], s[3 * 33]); o.z = pk2(s[4 * 33], s[5 * 33]); o.w = pk2(s[6 * 33], s[7 * 33]);
        *(GAS v4u*)(WT + (size_t)wt_row<MODE>(n0 + n, row_off) * K + k0 + 8 * c) = o; }
    LDS_WAIT(); asm volatile("" ::: "memory");
}
__device__ __forceinline__ void p0_prologue(Frame& F) {
    const int lane = lane_id(), tid = F.wave * 64 + lane;
    LAS float* sil = (LAS float*)(F.lds + LDSCTL_OFF + 1024);
    float* MODP = (float*)(F.ws + WS_MODP);
    for (int task = F.vcu; task < 192; task += F.G) {
        const int kc = task / 12, jb = task % 12;
        __syncthreads();
        if (tid < 192) { const int v = tid >> 6, k = kc * 64 + (tid & 63); const float cv = (v < 2) ? F.c[v * DM + k] : F.c_ctx[k]; sil[tid] = cv / (1.0f + __expf(-cv)); }
        __syncthreads();
        const int j = jb * 512 + tid; const float* wp = F.w_ada + (size_t)(kc * 64) * (6 * DM) + j; float a0 = 0.f, a1 = 0.f, a2 = 0.f;
#pragma unroll 16
        for (int kk = 0; kk < 64; ++kk) { const float w = wp[(size_t)kk * (6 * DM)]; a0 += sil[kk] * w; a1 += sil[64 + kk] * w; a2 += sil[128 + kk] * w; }
        MODP[(size_t)(kc * 3 + 0) * (6 * DM) + j] = a0; MODP[(size_t)(kc * 3 + 1) * (6 * DM) + j] = a1; MODP[(size_t)(kc * 3 + 2) * (6 * DM) + j] = a2;
    }
    if (F.vcu == (192 % F.G)) {
        float* cosT = (float*)(F.ws + WS_ROPE); float* sinT = cosT + 128 * 16;
        for (int i = tid; i < 2048; i += NWAVES * 64) { const int pos = i >> 4, f = i & 15;
            const double b4 = (f & 3) == 0 ? 1.0 : ((f & 3) == 1 ? 0.5623413251903491 : ((f & 3) == 2 ? 0.31622776601683794 : 0.1778279410038923));
            const double p10 = (f >> 2) == 0 ? 1.0 : ((f >> 2) == 1 ? 0.1 : ((f >> 2) == 2 ? 0.01 : 0.001));
            const double ang = (double)pos * (b4 * p10); const double kq = __builtin_rint(ang * 0.6366197723675814);
            const double r = (ang - kq * 1.5707963267948966) - kq * 6.123233995736766e-17; const int q = ((int)kq) & 3; const double r2 = r * r;
            const double s = r * (1.0 + r2 * (-1.0 / 6 + r2 * (1.0 / 120 + r2 * (-1.0 / 5040 + r2 * (1.0 / 362880 + r2 * (-1.0 / 39916800 + r2 * (1.0 / 6227020800.0)))))));
            const double c = 1.0 + r2 * (-0.5 + r2 * (1.0 / 24 + r2 * (-1.0 / 720 + r2 * (1.0 / 40320 + r2 * (-1.0 / 3628800 + r2 * (1.0 / 479001600.0 + r2 * (-1.0 / 87178291200.0)))))));
            const double cc = q == 0 ? c : (q == 1 ? -s : (q == 2 ? -c : s)), ss = q == 0 ? s : (q == 1 ? c : (q == 2 ? -s : -c));
            cosT[i] = (float)cc; sinT[i] = (float)ss; }
    }
    __syncthreads();
    LAS float* scr = (LAS float*)(F.lds + RING_OFF + F.wave * 16384);
    const int gw = F.vcu * NWAVES + F.wave, NGW = F.G * NWAVES;
    constexpr int I_IN = (DM / 64) * (INW / 32), I_O = (DM / 64) * (DM / 32), I_E = (DM / 64) * (DEXP / 32);
    constexpr int NITEMS = I_IN + I_O + 2 * NEXP * I_E;
    bf16* WIN = (bf16*)(F.ws + WS_WIN); bf16* WO = (bf16*)(F.ws + WS_WO); bf16* WGU = (bf16*)(F.ws + WS_WGU);
    for (int it = gw; it < NITEMS; it += NGW) {
        int r = it;
        if (r < I_IN) { p0_transpose_item<1>(F.w_in, DM, INW, WIN, 0, scr, r, lane); continue; } r -= I_IN;
        if (r < I_O) { p0_transpose_item<0>(F.w_out, DM, DM, WO, 0, scr, r, lane); continue; } r -= I_O;
        const int mat = r / (NEXP * I_E), rr = r % (NEXP * I_E), e = rr / I_E, ie = rr % I_E;
        if (mat == 0) p0_transpose_item<2>(F.w_gate + (size_t)e * DM * DEXP, DM, DEXP, WGU, e * 2 * DEXP, scr, ie, lane);
        else p0_transpose_item<3>(F.w_up + (size_t)e * DM * DEXP, DM, DEXP, WGU, e * 2 * DEXP, scr, ie, lane);
    }
}

__device__ __forceinline__ void convert_wdown(Frame& F, int hr, int nh) {
    const int lane = lane_id(); LAS float* scr = (LAS float*)(F.lds + RING_OFF + F.wave * 16384);
    constexpr int I_E = (DEXP / 64) * (DM / 32); bf16* WD = (bf16*)(F.ws + WS_WD);
    for (int it = hr * NWAVES + F.wave; it < NEXP * I_E; it += nh * NWAVES) { const int e = it / I_E, ie = it % I_E;
        p0_transpose_item<0>(F.w_down + (size_t)e * DEXP * DM, DEXP, DM, WD, e * DM, scr, ie, lane); }
}

__device__ __forceinline__ float mod_sum(const float* MODP, const float* b_ada, int v, int col) {
    float s = b_ada[col];
#pragma unroll
    for (int kc = 0; kc < 16; ++kc) s += MODP[(size_t)(kc * 3 + v) * (6 * DM) + col];
    return s;
}
__device__ __forceinline__ void p1_norm(Frame& F) {
    const int lane = lane_id(), tid = F.wave * 64 + lane;
    const float* MODP = (const float*)(F.ws + WS_MODP); float* MODF = (float*)(F.ws + WS_MODF);
    LAS float* tA = (LAS float*)(F.lds); LAS float* tB = tA + 3 * DM;
    for (int idx = tid; idx < 3 * 2 * DM; idx += NWAVES * 64) { const int v = idx / (2 * DM), q = idx % (2 * DM); const float s = mod_sum(MODP, F.b_ada, v, q);
        if (q < DM) tB[v * DM + q] = s; else tA[v * DM + q - DM] = F.g_mix[q - DM] * (1.0f + s); }
    for (int o = F.vcu * (NWAVES * 64) + tid; o < 3 * 6 * DM; o += F.G * NWAVES * 64) MODF[o] = mod_sum(MODP, F.b_ada, o / (6 * DM), o % (6 * DM));
    __syncthreads();
    bf16* XN = (bf16*)(F.ws + WS_XN);
    const int gw = F.vcu * NWAVES + F.wave, NGW = F.G * NWAVES;
    for (int m = gw; m < MALL; m += NGW) {
        const int v = m < SEQ ? 0 : (m < MTOK ? 1 : 2);
        const float* src = m < MTOK ? F.x + (size_t)m * DM : F.ctx + (size_t)(m - MTOK) * DM;
        const GAS f32x4* xr = (const GAS f32x4*)src + lane;
        f32x4 xv[4]; float ss = 0.f;
#pragma unroll
        for (int j = 0; j < 4; ++j) { xv[j] = xr[64 * j]; ss += (xv[j].x * xv[j].x + xv[j].y * xv[j].y) + (xv[j].z * xv[j].z + xv[j].w * xv[j].w); }
        const float rstd = 1.0f / sqrtf(wave_sum(ss) * (1.0f / DM) + EPS_RMS);
        GAS unsigned long long* o8 = (GAS unsigned long long*)(XN + (size_t)m * DM) + lane;
#pragma unroll
        for (int j = 0; j < 4; ++j) { const f32x4 a = *(const LAS f32x4*)(tA + v * DM + 4 * lane + 256 * j), sh = *(const LAS f32x4*)(tB + v * DM + 4 * lane + 256 * j);
            const f32x4 h = xv[j] * rstd * a + sh;
            o8[64 * j] = (unsigned long long)cvtpk(h.x, h.y) | ((unsigned long long)cvtpk(h.z, h.w) << 32); }
    }
}

#define MFMA32(a, b, c) __builtin_amdgcn_mfma_f32_32x32x16_bf16((a), (b), (c), 0, 0, 0)
__device__ __forceinline__ int crow(int r, int hi) { return (r & 3) + 8 * (r >> 2) + 4 * hi; }
__device__ __forceinline__ bf16x8 pack8(const f32x16& p, int s) {
    v4u w; w.x = cvtpk(p[8 * s + 0], p[8 * s + 1]); w.y = cvtpk(p[8 * s + 2], p[8 * s + 3]); w.z = cvtpk(p[8 * s + 4], p[8 * s + 5]); w.w = cvtpk(p[8 * s + 6], p[8 * s + 7]);
    return __builtin_bit_cast(bf16x8, w);
}
constexpr int ATT_KBUF = 0, ATT_VBUF = 8192, ATT_BUF = 16384;
__device__ __forceinline__ void attn_unit(Frame& F, int u) {
    const int b = u >> 7, kvh = (u >> 6) & 1, n = u & 63;
    const int lane = lane_id(), tid = F.wave * 64 + lane, r32 = lane & 31, hh = lane >> 5, g = F.wave >> 1, half = F.wave & 1, h = kvh * 4 + g;
    const bf16* Q = (const bf16*)(F.ws + WS_Q); bf16* MIX = (bf16*)(F.ws + WS_MIX);
    const bf16* Kbase = (const bf16*)(F.ws + WS_K) + (size_t)(b * NKVH + kvh) * KVROWS * HDIM;
    const bf16* Vbase = (const bf16*)(F.ws + WS_VT) + (size_t)(b * NKVH + kvh) * HDIM * KVROWS;
    const float sk2 = F.sink[h] * 1.4426950408889634f;
    const int q0 = n * 128 + half * 64;
    const int ntiles = (n == 0 || n == SEQ / 128 - 1) ? 8 : 10, tskip = (n == 0) ? 2 : 0;
    const int srow = tid >> 3, sc = tid & 7;
    const unsigned kw_off = (unsigned)(srow * 128 + ((sc ^ ((srow >> 1) & 7)) << 4));
    const int vg = (srow >> 1) & 15; const unsigned vw_off = (unsigned)(srow * 128 + ((sc ^ (vg >> 1)) << 4)); const bool vswap = (vg & 1) != 0;
    v4u kreg, vreg;
#define ATT_TILE_ROW(idx) (((idx) < 4) ? (idx) * 64 : CTXL + n * 128 - 128 + ((idx) + tskip - 4) * 64)
#define ATT_LOAD(idx) do { const int kr_ = ATT_TILE_ROW(idx); kreg = *(const v4u*)(Kbase + (size_t)kr_ * HDIM + tid * 8); vreg = *(const v4u*)(Vbase + (size_t)srow * KVROWS + kr_ + sc * 8); } while (0)
#define ATT_STORE(bufi) do { LAS unsigned char* tb_ = F.lds + (bufi) * ATT_BUF; *(LAS v4u*)(tb_ + ATT_KBUF + kw_off) = kreg; \
        v4u vv_ = vreg; if (vswap) { vv_.x = vreg.z; vv_.y = vreg.w; vv_.z = vreg.x; vv_.w = vreg.y; } *(LAS v4u*)(tb_ + ATT_VBUF + vw_off) = vv_; } while (0)
    __syncthreads();
    ATT_LOAD(0);
    LAS unsigned char* qlds = F.lds + 2 * ATT_BUF + F.wave * 8192 + lane * 16;
#pragma unroll
    for (int sb = 0; sb < 2; ++sb)
#pragma unroll
        for (int s = 0; s < 4; ++s) *(LAS bf16x8*)(qlds + (sb * 4 + s) * 1024) = *(const bf16x8*)(Q + (size_t)(b * SEQ + q0 + sb * 32 + r32) * ATTW + h * HDIM + 16 * s + 8 * hh);
    f32x16 o[2][2]; float mrun[2], lrun[2];
#pragma unroll
    for (int sb = 0; sb < 2; ++sb) { mrun[sb] = sk2; lrun[sb] = hh == 0 ? 1.0f : 0.0f;
#pragma unroll
        for (int db = 0; db < 2; ++db)
#pragma unroll
            for (int i = 0; i < 16; ++i) o[sb][db][i] = 0.f; }
    ATT_STORE(0);
    __syncthreads();
    unsigned kro[2];
#pragma unroll
    for (int kb = 0; kb < 2; ++kb) { const int row = kb * 32 + r32; kro[kb] = (unsigned)(ATT_KBUF + row * 128); }
    const int ksw = (r32 >> 1) & 7;
    const int vsw = (r32 >> 1) & 15;
    for (int idx = 0; idx < ntiles; ++idx) {
        const int cur = idx & 1;
        if (idx + 1 < ntiles) ATT_LOAD(idx + 1);
        const LAS unsigned char* tb = F.lds + cur * ATT_BUF;
        bf16x8 kf[2][4], vf[2][4];
#pragma unroll
        for (int kb = 0; kb < 2; ++kb)
#pragma unroll
            for (int s = 0; s < 4; ++s) kf[kb][s] = *(const LAS bf16x8*)(tb + kro[kb] + (((2 * s + hh) ^ ksw) << 4));
#pragma unroll
        for (int db = 0; db < 2; ++db)
#pragma unroll
            for (int ks = 0; ks < 4; ++ks) { const LAS unsigned char* vr = tb + ATT_VBUF + (db * 32 + r32) * 128;
                const v2u lo = *(const LAS v2u*)(vr + (((4 * ks + hh) ^ vsw) << 3)), hi = *(const LAS v2u*)(vr + (((4 * ks + 2 + hh) ^ vsw) << 3));
                v4u w; w.x = lo.x; w.y = lo.y; w.z = hi.x; w.w = hi.y; vf[db][ks] = __builtin_bit_cast(bf16x8, w); }
        const int tile = idx < 4 ? idx : idx + tskip;
        const bool needmask = tile >= 4 && (tile < 6 || tile >= 8);
        const int kpos0 = n * 128 - 128 + (tile - 4) * 64;
#pragma unroll
        for (int sb = 0; sb < 2; ++sb) {
            f32x16 p0, p1;
#pragma unroll
            for (int i = 0; i < 16; ++i) { p0[i] = 0.f; p1[i] = 0.f; }
#pragma unroll
            for (int s = 0; s < 4; ++s) { const bf16x8 qv = *(const LAS bf16x8*)(qlds + (sb * 4 + s) * 1024); p0 = MFMA32(kf[0][s], qv, p0); p1 = MFMA32(kf[1][s], qv, p1); }
            if (needmask) { const int qpos = q0 + sb * 32 + r32;
#pragma unroll
                for (int i = 0; i < 16; ++i) { const int dk = kpos0 + crow(i, hh) - qpos; if (dk > 128 || dk < -128) p0[i] = -1e30f; if (dk + 32 > 128 || dk + 32 < -128) p1[i] = -1e30f; } }
            float mx = fmaxf(p0[0], p1[0]);
#pragma unroll
            for (int i = 1; i < 16; ++i) mx = fmaxf(mx, fmaxf(p0[i], p1[i]));
            mx = fmaxf(mx, __shfl_xor(mx, 32));
            const float mold = mrun[sb], mnew = fmaxf(mold, mx); mrun[sb] = mnew;
            if (__any(mnew > mold)) { const float alpha = __builtin_amdgcn_exp2f(mold - mnew); lrun[sb] *= alpha;
#pragma unroll
                for (int db = 0; db < 2; ++db)
#pragma unroll
                    for (int i = 0; i < 16; ++i) o[sb][db][i] *= alpha; }
            float ps = 0.f;
#pragma unroll
            for (int i = 0; i < 16; ++i) { p0[i] = __builtin_amdgcn_exp2f(p0[i] - mnew); p1[i] = __builtin_amdgcn_exp2f(p1[i] - mnew); ps += p0[i] + p1[i]; }
            lrun[sb] += ps;
            bf16x8 pb[4]; pb[0] = pack8(p0, 0); pb[1] = pack8(p0, 1); pb[2] = pack8(p1, 0); pb[3] = pack8(p1, 1);
#pragma unroll
            for (int db = 0; db < 2; ++db)
#pragma unroll
                for (int ks = 0; ks < 4; ++ks) o[sb][db] = MFMA32(vf[db][ks], pb[ks], o[sb][db]);
        }
        if (idx + 1 < ntiles) ATT_STORE(cur ^ 1);
        __syncthreads();
    }
#undef ATT_TILE_ROW
#undef ATT_LOAD
#undef ATT_STORE
#pragma unroll
    for (int sb = 0; sb < 2; ++sb) { const float lt = lrun[sb] + __shfl_xor(lrun[sb], 32), inv = 1.0f / lt;
        bf16* dst = MIX + (size_t)(b * SEQ + q0 + sb * 32 + r32) * DM + h * HDIM;
#pragma unroll
        for (int db = 0; db < 2; ++db)
#pragma unroll
            for (int g4 = 0; g4 < 4; ++g4) { v2u w; w.x = cvtpk(o[sb][db][4 * g4] * inv, o[sb][db][4 * g4 + 1] * inv); w.y = cvtpk(o[sb][db][4 * g4 + 2] * inv, o[sb][db][4 * g4 + 3] * inv);
                *(v2u*)(dst + db * 32 + 8 * g4 + 4 * hh) = w; } }
}
__device__ __forceinline__ void unpack8(const v4u w, float (&f)[8]) { f[0] = bflo(w.x); f[1] = bfhi(w.x); f[2] = bflo(w.y); f[3] = bfhi(w.y); f[4] = bflo(w.z); f[5] = bfhi(w.z); f[6] = bflo(w.w); f[7] = bfhi(w.w); }
__device__ __forceinline__ void p3_attn_conv(Frame& F) {
    const int tid = F.wave * 64 + lane_id();
    for (int u = F.vcu; u < BATCH * NKVH * (SEQ / 128); u += F.G) attn_unit(F, u);
    const bf16* BG = (const bf16*)(F.ws + WS_BG); const bf16* CG = (const bf16*)(F.ws + WS_CG); const bf16* HV = (const bf16*)(F.ws + WS_HV); bf16* MIX = (bf16*)(F.ws + WS_MIX);
    for (int idx = F.vcu * (NWAVES * 64) + tid; idx < MTOK * (CONVW / 8); idx += F.G * NWAVES * 64) {
        const int row = idx >> 6, c8 = (idx & 63) * 8, t = row & (SEQ - 1); const size_t off = (size_t)row * CONVW + c8;
        float bgv[8], uc[8], up[8], un[8], a[8], bq[8];
        unpack8(*(const v4u*)(BG + off), bgv);
        unpack8(*(const v4u*)(CG + off), a); unpack8(*(const v4u*)(HV + off), bq);
#pragma unroll
        for (int i = 0; i < 8; ++i) uc[i] = a[i] * bq[i];
        if (t > 0) { unpack8(*(const v4u*)(CG + off - CONVW), a); unpack8(*(const v4u*)(HV + off - CONVW), bq);
#pragma unroll
            for (int i = 0; i < 8; ++i) up[i] = a[i] * bq[i]; }
        else {
#pragma unroll
            for (int i = 0; i < 8; ++i) up[i] = 0.f; }
        if (t < SEQ - 1) { unpack8(*(const v4u*)(CG + off + CONVW), a); unpack8(*(const v4u*)(HV + off + CONVW), bq);
#pragma unroll
            for (int i = 0; i < 8; ++i) un[i] = a[i] * bq[i]; }
        else {
#pragma unroll
            for (int i = 0; i < 8; ++i) un[i] = 0.f; }
        float r[8];
#pragma unroll
        for (int i = 0; i < 8; ++i) r[i] = bgv[i] * (F.conv_w[c8 + i] * up[i] + F.conv_w[CONVW + c8 + i] * uc[i] + F.conv_w[2 * CONVW + c8 + i] * un[i]);
        v4u w; w.x = cvtpk(r[0], r[1]); w.y = cvtpk(r[2], r[3]); w.z = cvtpk(r[4], r[5]); w.w = cvtpk(r[6], r[7]);
        *(v4u*)(MIX + (size_t)row * DM + ATTW + c8) = w;
    }
}

__device__ __forceinline__ void p5_norm_router(Frame& F) {
    const int lane = lane_id(), tid = F.wave * 64 + lane;
    const float* MODF = (const float*)(F.ws + WS_MODF);
    LAS float* wr = (LAS float*)(F.lds);
    LAS float* tA = wr + NEXP * DM; LAS float* tB = tA + 2 * DM;
    for (int i = tid; i < NEXP * DM; i += NWAVES * 64) { const int k = i >> 4, e = i & 15; wr[e * DM + k] = F.w_router[i]; }
    for (int i = tid; i < 2 * DM; i += NWAVES * 64) { const int b = i >> 10, k = i & (DM - 1);
        tA[i] = F.g_ffn[k] * (1.0f + MODF[(size_t)b * 6 * DM + 4 * DM + k]); tB[i] = MODF[(size_t)b * 6 * DM + 3 * DM + k]; }
    __syncthreads();
    bf16* H2 = (bf16*)(F.ws + WS_H2); float* AFF = (float*)(F.ws + WS_AFF);
    const int gw = F.vcu * NWAVES + F.wave, NGW = F.G * NWAVES;
    for (int m = gw; m < MTOK; m += NGW) {
        const int b = m >> 13, t = m & (SEQ - 1);
        const GAS f32x4* xr = (const GAS f32x4*)(F.out + (size_t)m * DM) + lane;
        f32x4 hv[4]; float ss = 0.f;
#pragma unroll
        for (int j = 0; j < 4; ++j) { hv[j] = xr[64 * j]; ss += (hv[j].x * hv[j].x + hv[j].y * hv[j].y) + (hv[j].z * hv[j].z + hv[j].w * hv[j].w); }
        const float rstd = 1.0f / sqrtf(wave_sum(ss) * (1.0f / DM) + EPS_RMS);
        GAS unsigned long long* o8 = (GAS unsigned long long*)(H2 + (size_t)m * DM) + lane;
#pragma unroll
        for (int j = 0; j < 4; ++j) { const f32x4 a = *(const LAS f32x4*)(tA + b * DM + 4 * lane + 256 * j), sh = *(const LAS f32x4*)(tB + b * DM + 4 * lane + 256 * j);
            hv[j] = hv[j] * rstd * a + sh;
            o8[64 * j] = (unsigned long long)cvtpk(hv[j].x, hv[j].y) | ((unsigned long long)cvtpk(hv[j].z, hv[j].w) << 32); }
        float r8[8];
#pragma unroll
        for (int e = 0; e < 8; ++e) { float s0 = 0.f, s1 = 0.f;
#pragma unroll
            for (int j = 0; j < 4; ++j) { const f32x4 w0 = *(const LAS f32x4*)(wr + e * DM + 4 * lane + 256 * j), w1 = *(const LAS f32x4*)(wr + (e + 8) * DM + 4 * lane + 256 * j);
                s0 += (hv[j].x * w0.x + hv[j].y * w0.y) + (hv[j].z * w0.z + hv[j].w * w0.w); s1 += (hv[j].x * w1.x + hv[j].y * w1.y) + (hv[j].z * w1.z + hv[j].w * w1.w); }
            const bool up = (lane & 32) != 0; r8[e] = (up ? s1 : s0) + __shfl_xor(up ? s0 : s1, 32);
            asm volatile("" ::: "memory"); }
        float r4[4], r2[2];
#pragma unroll
        for (int e = 0; e < 4; ++e) { const bool up = (lane & 16) != 0; r4[e] = (up ? r8[e + 4] : r8[e]) + __shfl_xor(up ? r8[e] : r8[e + 4], 16); }
#pragma unroll
        for (int e = 0; e < 2; ++e) { const bool up = (lane & 8) != 0; r2[e] = (up ? r4[e + 2] : r4[e]) + __shfl_xor(up ? r4[e] : r4[e + 2], 8); }
        float lg; { const bool up = (lane & 4) != 0; lg = (up ? r2[1] : r2[0]) + __shfl_xor(up ? r2[0] : r2[1], 4); }
        lg += __shfl_xor(lg, 2); lg += __shfl_xor(lg, 1);
        float mx = lg;
#pragma unroll
        for (int o = 4; o < 64; o <<= 1) mx = fmaxf(mx, __shfl_xor(mx, o));
        const float ex = __expf(lg - mx); float den = ex;
#pragma unroll
        for (int o = 4; o < 64; o <<= 1) den += __shfl_xor(den, o);
        const float mine = ex / den; const int myexp = ((lane >> 5) & 1) * 8 + ((lane >> 4) & 1) * 4 + ((lane >> 3) & 1) * 2 + ((lane >> 2) & 1);
        if ((lane & 3) == 0) AFF[(size_t)(b * NEXP + myexp) * SEQ + t] = mine;
    }
}

__device__ __forceinline__ int block_excl_scan(int v, LAS int* wsum, int lane, int wave, int& total) {
    int x = v;
#pragma unroll
    for (int o = 1; o < 64; o <<= 1) { const int y = __shfl_up(x, o); if (lane >= o) x += y; }
    if (lane == 63) wsum[wave] = x;
    __syncthreads();
    int base = 0, tot = 0;
#pragma unroll
    for (int w = 0; w < NWAVES; ++w) { const int s = wsum[w]; base += (w < wave) ? s : 0; tot += s; }
    __syncthreads();
    total = tot; return base + x - v;
}
__device__ __forceinline__ void p6_topk_task(Frame& F, int task) {
    const int b = task >> 7, e = (task >> 3) & 15, part = task & 7, lane = lane_id(), tid = F.wave * 64 + lane;
    LAS unsigned* keys = (LAS unsigned*)(F.lds);
    LAS unsigned* hist = (LAS unsigned*)(F.lds + 32768);
    LAS int* misc = (LAS int*)(F.lds + 32768 + 1024);
    const float* aff = (const float*)(F.ws + WS_AFF) + (size_t)(b * NEXP + e) * SEQ;
    __syncthreads();
    for (int i = tid; i < SEQ / 4; i += NWAVES * 64) *(LAS v4u*)(keys + 4 * i) = *(const v4u*)(aff + 4 * i);
    __syncthreads();
    unsigned prefix = 0u, mask = 0u; int kk = CAP;
    for (int pass = 3; pass >= 0; --pass) {
        if (tid < 256) hist[tid] = 0u;
        __syncthreads();
        const int sh = pass * 8;
#pragma unroll 4
        for (int j = 0; j < 16; ++j) { const unsigned k = keys[tid + 512 * j]; if ((k & mask) == prefix) __hip_atomic_fetch_add(hist + ((k >> sh) & 255u), 1u, __ATOMIC_RELAXED, __HIP_MEMORY_SCOPE_WORKGROUP); }
        __syncthreads();
        if (F.wave == 0) {
            const int c0 = (int)hist[255 - 4 * lane], c1 = (int)hist[254 - 4 * lane], c2 = (int)hist[253 - 4 * lane], c3 = (int)hist[252 - 4 * lane];
            const int s = c0 + c1 + c2 + c3; int incl = s;
#pragma unroll
            for (int o = 1; o < 64; o <<= 1) { const int y = __shfl_up(incl, o); if (lane >= o) incl += y; }
            const int excl = incl - s;
            if (excl < kk && incl >= kk) { const int r = kk - excl; int bin, above;
                if (r <= c0) { bin = 255 - 4 * lane; above = 0; } else if (r <= c0 + c1) { bin = 254 - 4 * lane; above = c0; }
                else if (r <= c0 + c1 + c2) { bin = 253 - 4 * lane; above = c0 + c1; } else { bin = 252 - 4 * lane; above = c0 + c1 + c2; }
                misc[0] = bin; misc[1] = r - above; }
        }
        __syncthreads();
        prefix |= (unsigned)misc[0] << sh; mask |= 255u << sh; kk = misc[1];
        __syncthreads();
    }
    const unsigned thr = prefix; const int need = kk;
    const int t0 = part * (SEQ / 8);
    int cgt = 0, ceq = 0;
#pragma unroll 4
    for (int j = 0; j < 16; ++j) { const int i = tid + 512 * j; const unsigned k = keys[i]; if (i < t0) { cgt += (k > thr) ? 1 : 0; ceq += (k == thr) ? 1 : 0; } }
    int gt_before, eq_before;
    (void)block_excl_scan(cgt, misc + 16, lane, F.wave, gt_before);
    (void)block_excl_scan(ceq, misc + 16, lane, F.wave, eq_before);
    const int tA = t0 + 2 * tid; const unsigned kA = keys[tA], kB = keys[tA + 1];
    const int eqA = (kA == thr) ? 1 : 0, eqB = (kB == thr) ? 1 : 0; int dummy;
    const int eqx = block_excl_scan(eqA + eqB, misc + 16, lane, F.wave, dummy);
    const int eposA = eq_before + eqx, eposB = eposA + eqA;
    const int selA = (kA > thr || (eqA && eposA < need)) ? 1 : 0, selB = (kB > thr || (eqB && eposB < need)) ? 1 : 0;
    int nloc;
    const int sx = block_excl_scan(selA + selB, misc + 16, lane, F.wave, nloc);
    const int sel_before = gt_before + (eq_before < need ? eq_before : need);
    int* SEL = (int*)(F.ws + WS_SEL); float* GSEL = (float*)(F.ws + WS_GSEL); int* ROWIDX = (int*)(F.ws + WS_ROWIDX);
    const int slotA = sel_before + sx, slotB = slotA + selA; const size_t eb = (size_t)(e * 2 + b) * CAP;
    SEL[(size_t)(b * SEQ + tA) * NEXP + e] = selA ? slotA : -1; SEL[(size_t)(b * SEQ + tA + 1) * NEXP + e] = selB ? slotB : -1;
    if (selA) { GSEL[eb + slotA] = __uint_as_float(kA); ROWIDX[eb + slotA] = b * SEQ + tA; }
    if (selB) { GSEL[eb + slotB] = __uint_as_float(kB); ROWIDX[eb + slotB] = b * SEQ + tA + 1; }
}

__device__ __forceinline__ void p9_final(Frame& F, float* dst_base) {
    const int lane = lane_id();
    const float* MODF = (const float*)(F.ws + WS_MODF); const int* SEL = (const int*)(F.ws + WS_SEL); const bf16* Y = (const bf16*)(F.ws + WS_Y);
    const int gw = F.vcu * NWAVES + F.wave, NGW = F.G * NWAVES;
    for (int m = gw; m < MTOK; m += NGW) {
        const int b = m >> 13;
        GAS f32x4* xr = (GAS f32x4*)(F.out + (size_t)m * DM) + lane;
        f32x4 xv[4], acc[4];
#pragma unroll
        for (int j = 0; j < 4; ++j) { xv[j] = xr[64 * j]; acc[j] = (f32x4){0.f, 0.f, 0.f, 0.f}; }
        const int selv = (lane < NEXP) ? SEL[(size_t)m * NEXP + lane] : -1;
#pragma unroll
        for (int e = 0; e < NEXP; ++e) { const int s = __builtin_amdgcn_readlane(selv, e);
            if (s >= 0) { const GAS v2u* yr = (const GAS v2u*)(Y + ((size_t)(e * 2 + b) * CAP + s) * DM) + lane;
#pragma unroll
                for (int j = 0; j < 4; ++j) { const v2u w = yr[64 * j]; acc[j].x += bflo(w.x); acc[j].y += bfhi(w.x); acc[j].z += bflo(w.y); acc[j].w += bfhi(w.y); } } }
        float ss = 0.f;
#pragma unroll
        for (int j = 0; j < 4; ++j) { const f32x4 gt = *(const f32x4*)(MODF + (size_t)b * 6 * DM + 5 * DM + 4 * lane + 256 * j);
            xv[j] = xv[j] + gt * acc[j]; ss += (xv[j].x * xv[j].x + xv[j].y * xv[j].y) + (xv[j].z * xv[j].z + xv[j].w * xv[j].w); }
        const float rstd = 1.0f / sqrtf(wave_sum(ss) * (1.0f / DM) + EPS_RMS);
#pragma unroll
        for (int j = 0; j < 4; ++j) { const f32x4 gf = *(const f32x4*)(F.g_final + 4 * lane + 256 * j); ((GAS f32x4*)(dst_base + (size_t)m * DM) + lane)[64 * j] = xv[j] * rstd * gf; }
    }
}

struct Args { const float* in[17]; float* out; unsigned char* ws; int ph_lo, ph_hi; };
__global__ void __launch_bounds__(NWAVES * 64, 2) dit_fwd(Args args) {
    extern __shared__ __attribute__((aligned(16))) unsigned char lds[];
    Frame F;
    F.lds = (LAS unsigned char*)lds;
    F.MISC = (volatile LAS unsigned*)(F.lds + MISC_OFF);
    F.wave = __builtin_amdgcn_readfirstlane((int)threadIdx.x >> 6);
    F.G = gridDim.x; { const int bx = blockIdx.x; F.vcu = (F.G % 8 == 0) ? (bx % 8) * (F.G / 8) + bx / 8 : bx; }
    F.ws = args.ws; F.out = args.out; F.ctl = (gu32*)(args.ws + WS_CTL);
    F.x = args.in[0]; F.c = args.in[1]; F.ctx = args.in[2]; F.c_ctx = args.in[3]; F.w_ada = args.in[4]; F.b_ada = args.in[5]; F.g_mix = args.in[6]; F.w_in = args.in[7];
    F.conv_w = args.in[8]; F.sink = args.in[9]; F.w_out = args.in[10]; F.g_ffn = args.in[11]; F.w_router = args.in[12]; F.w_gate = args.in[13]; F.w_up = args.in[14];
    F.w_down = args.in[15]; F.g_final = args.in[16];
    for (int u = ftid(F); u < (LDS_BYTES - LDSCTL_OFF) / 4; u += NWAVES * 64) ((LAS unsigned*)(F.lds + LDSCTL_OFF))[u] = 0u;
    __syncthreads();
    XcdBarrier bar; bar.bar = (unsigned*)(F.ctl + CW_BAR); bar.x = 0; bar.st = nullptr; bar.w = F.wave;
    if (N_LAUNCHES == 1) bar = xcd_barrier_post((unsigned*)(F.ctl + CW_BAR), F.MISC + 8, F.wave);
    const int lo = args.ph_lo, hi = args.ph_hi;
#ifdef DBG_ONLY
#define IN(k) ((k) == DBG_ONLY && lo <= (k) && (k) < hi)
#else
#define IN(k) (lo <= (k) && (k) < hi)
#endif
#define SEAM(k) do { if (IN(k) && IN((k) + 1)) xcd_barrier(bar); } while (0)
#ifdef DBG_DUP
#define REP(k) for (int rep_ = 0; rep_ < ((k) == DBG_DUP ? 2 : 1); ++rep_)
#define REPBAR(k) do { if ((k) == DBG_DUP && rep_ == 0 && N_LAUNCHES == 1) xcd_barrier(bar); } while (0)
#else
#define REP(k)
#define REPBAR(k) do { } while (0)
#endif

    if (IN(0)) { REP(0) { p0_prologue(F); REPBAR(0); } SEAM(0); }
    if (IN(1)) { REP(1) { p1_norm(F); REPBAR(1); } SEAM(1); }
    if (IN(2)) {
        pg8::Gemm g{(const pg8::bf16_t*)(F.ws + WS_XN), (const pg8::bf16_t*)(F.ws + WS_WIN), MALL, INW, DM};
        pg8::InProjOrder S{F.G, (int)blockIdx.x};
        const float* cosT = (const float*)(F.ws + WS_ROPE);
        pg8::EpiInProj E{(pg8::bf16_t*)(F.ws + WS_Q), (pg8::bf16_t*)(F.ws + WS_K), (pg8::bf16_t*)(F.ws + WS_VT), (pg8::bf16_t*)(F.ws + WS_BG), cosT, cosT + 128 * 16};
        static_assert(WS_CG == WS_BG + (size_t)MTOK * CONVW * 2 && WS_HV == WS_CG + (size_t)MTOK * CONVW * 2, "bg | cg | hv contiguous");
        REP(2) { pg8::gemm_phase<pg8::EpiInProj, pg8::InProjOrder, PG8_ALIGN, PG8_SP2>(F.lds + RING_OFF, g, S, E, F.wave); REPBAR(2); }
        { const int rem = (MTOK / 256 * 9 + 2) % F.G, c = (int)blockIdx.x;
          if (rem == 0) convert_wdown(F, c, F.G); else if (c >= rem) convert_wdown(F, c - rem, F.G - rem); }
        SEAM(2);
    }
    if (IN(3)) { REP(3) { p3_attn_conv(F); REPBAR(3); } SEAM(3); }
    if (IN(4)) {
        pg8::Gemm g{(const pg8::bf16_t*)(F.ws + WS_MIX), (const pg8::bf16_t*)(F.ws + WS_WO), MTOK, DM, DM};
        pg8::StaticOrder S; S.init(MTOK, DM, F.G, (int)blockIdx.x);
        pg8::EpiOutProj E{F.x, F.out, (const float*)(F.ws + WS_MODF)};
        REP(4) { pg8::gemm_phase<pg8::EpiOutProj, pg8::StaticOrder, PG8_ALIGN, PG8_SP2>(F.lds + RING_OFF, g, S, E, F.wave); REPBAR(4); }
        SEAM(4);
    }
    if (IN(5)) { REP(5) { p5_norm_router(F); REPBAR(5); } SEAM(5); }
    if (IN(6)) { REP(6) { for (int task = F.vcu; task < BATCH * NEXP * 8; task += F.G) p6_topk_task(F, task); REPBAR(6); } SEAM(6); }
    if (IN(7)) {
        pg8::Gemm g{(const pg8::bf16_t*)(F.ws + WS_H2), (const pg8::bf16_t*)(F.ws + WS_WGU), NEXP * 2 * CAP, NEXP * 2 * DEXP, DM};
        pg8::MoeOrder<8> S{F.G, (int)blockIdx.x, (const int*)(F.ws + WS_ROWIDX)};
        pg8::EpiGateUp E{(pg8::bf16_t*)(F.ws + WS_ACT)};
        REP(7) { pg8::gemm_phase<pg8::EpiGateUp, pg8::MoeOrder<8>, PG8_ALIGN, PG8_SP2, true>(F.lds + RING_OFF, g, S, E, F.wave); REPBAR(7); }
        SEAM(7);
    }
    if (IN(8)) {
        pg8::Gemm g{(const pg8::bf16_t*)(F.ws + WS_ACT), (const pg8::bf16_t*)(F.ws + WS_WD), NEXP * 2 * CAP, NEXP * DM, DEXP};
        pg8::MoeOrder<4> S{F.G, (int)blockIdx.x, nullptr};
        pg8::EpiDown E{(pg8::bf16_t*)(F.ws + WS_Y), (const float*)(F.ws + WS_GSEL)};
        REP(8) { pg8::gemm_phase<pg8::EpiDown, pg8::MoeOrder<4>, PG8_ALIGN, PG8_SP2>(F.lds + RING_OFF, g, S, E, F.wave); REPBAR(8); }
        SEAM(8);
    }
#if defined(DBG_DUP) && DBG_DUP == 9
    if (IN(9)) { p9_final(F, (float*)(F.ws + WS_WGU)); xcd_barrier(bar); p9_final(F, F.out); }
#elif defined(DBG_DUP) && DBG_DUP == 10
    if (IN(9)) { for (int i = 0; i < 8; ++i) xcd_barrier(bar); p9_final(F, F.out); }
#else
    if (IN(9)) { p9_final(F, F.out); }
#endif
#undef IN
#undef SEAM
}

extern "C" void kernel_launch(void* const* d_in, const int* in_sizes, int n_in, void* d_out, int out_size, void* d_ws, size_t ws_size, hipStream_t stream) {
    static int grid = 0;
    if (grid == 0) {
        if (n_in != 17 || in_sizes[0] != MTOK * DM || out_size != MTOK * DM || ws_size < WS_END) { fprintf(stderr, "kernel_launch: unexpected shapes (n_in %d, in0 %d, out %d, ws %zu); nothing launched\n", n_in, n_in > 0 ? in_sizes[0] : -1, out_size, ws_size); grid = -1; return; }
        int dev = 0, cus = 0, per_cu = 0;
        if (hipGetDevice(&dev) != hipSuccess || hipDeviceGetAttribute(&cus, hipDeviceAttributeMultiprocessorCount, dev) != hipSuccess) { fprintf(stderr, "kernel_launch: device query failed\n"); grid = -1; return; }
        if (hipFuncSetAttribute((const void*)dit_fwd, hipFuncAttributeMaxDynamicSharedMemorySize, LDS_BYTES) != hipSuccess) { fprintf(stderr, "kernel_launch: hipFuncSetAttribute failed\n"); grid = -1; return; }
        if (hipOccupancyMaxActiveBlocksPerMultiprocessor(&per_cu, (const void*)dit_fwd, NWAVES * 64, LDS_BYTES) != hipSuccess || per_cu < 1) { fprintf(stderr, "kernel_launch: occupancy query reports %d workgroups per CU\n", per_cu); per_cu = 1; }
        (void)hipGetLastError();
        grid = cus;
    }
    if (grid < 0) return;
    (void)hipMemsetAsync((char*)d_ws + WS_CTL, 0, CTL_ZERO_BYTES, stream);
    Args a{};
    for (int i = 0; i < 17; ++i) a.in[i] = (const float*)d_in[i];
    a.out = (float*)d_out; a.ws = (unsigned char*)d_ws;
    if (N_LAUNCHES == 1) { a.ph_lo = 0; a.ph_hi = NPH; hipLaunchKernelGGL(dit_fwd, dim3(grid), dim3(NWAVES * 64), LDS_BYTES, stream, a); }
    else for (int li = 0; li < NPH; ++li) { a.ph_lo = li; a.ph_hi = li + 1; hipLaunchKernelGGL(dit_fwd, dim3(grid), dim3(NWAVES * 64), LDS_BYTES, stream, a); }
}
```
